# Optimizing an MI355X kernel written in HIP

```python
import math
import jax, jax.numpy as jnp
from jax import lax
import numpy as np

D_MODEL = 1024
BATCH = 16
SEQ = 256
DEPTH = 4
DEC_BATCH = 2
DEC_SEQ = 2048
PAST_LEN = 512

GRID_W = 64
N_MIXERS = 2
N_HYENA = (DEPTH + 1) // 2
N_MLA = DEPTH // 2
EPS = 1e-6
HY_WIDTH = D_MODEL
SHORT_CONV = 3
FILTER_BANDS = 16
FILTER_EMB = 1 + 2 * FILTER_BANDS
FILTER_HIDDEN = 64
FAST_DECAY_PCT = 0.3
SLOW_DECAY_PCT = 1.5
DECAY_TARGET = 1e-2
N_HEADS = 16
Q_LORA = 384
KV_LORA = 256
QK_NOPE = 64
QK_ROPE = 32
V_HEAD = 64
ROPE_THETA = 10000.0
Q_BLOCK = 128
MLA_IN = Q_LORA + KV_LORA + QK_ROPE + N_HEADS * V_HEAD

kernel_name = 'hybrid_hyena_mla_diffusion_step'


def rmsnorm(x, g):
    xf = x.astype(jnp.float32)
    y = xf * lax.rsqrt(jnp.mean(xf * xf, axis=-1, keepdims=True) + EPS)
    return (y * g.astype(jnp.float32)).astype(x.dtype)


def adaln(cond, w, b):
    m = (jax.nn.silu(cond) @ w + b)[:, None, :]
    return jnp.split(m, 3, axis=-1)


def short_conv(u, w, b):
    L = u.shape[1]
    pad = SHORT_CONV // 2
    up = jnp.pad(u, ((0, 0), (pad, pad), (0, 0)))
    out = b
    for k in range(SHORT_CONV):
        out = out + up[:, k:k + L] * w[k]
    return out


def hyena_filters(L, w1, b1, freq, w2, b2, w3):
    f32 = jnp.float32
    t = jnp.linspace(0.0, 1.0, L, dtype=f32)[:, None]
    w = (2.0 * math.pi / L) * jnp.arange(L, dtype=f32)[:, None]
    bands = jnp.linspace(1e-4, FILTER_BANDS - 1, FILTER_BANDS, dtype=f32)[None, :]
    z = jnp.concatenate([t, jnp.cos(bands * w), -jnp.sin(bands * w)], axis=-1)
    fr = freq.astype(f32)
    hdn = jnp.sin(fr * (z @ w1.astype(f32) + b1.astype(f32)))
    hdn = jnp.sin(fr * (hdn @ w2.astype(f32) + b2.astype(f32)))
    h = hdn @ w3.astype(f32)
    max_decay = math.log(DECAY_TARGET) / FAST_DECAY_PCT
    min_decay = math.log(DECAY_TARGET) / SLOW_DECAY_PCT
    deltas = jnp.abs(jnp.linspace(min_decay, max_decay, HY_WIDTH, dtype=f32))
    deltas = jnp.concatenate([deltas, deltas])
    h = h * jnp.exp(-t * deltas)
    return h / jnp.sum(jnp.abs(h), axis=0, keepdims=True)


def hyena_mix(h, w_in, conv_w, conv_b, f_w1, f_b1, f_freq, f_w2, f_b2, f_w3, f_bias, w_out):
    L = h.shape[1]
    n = 2 * L
    proj = h @ w_in
    u = short_conv(proj[..., :3 * HY_WIDTH], conv_w, conv_b)
    gate = proj[..., 3 * HY_WIDTH:]
    x0, x1, v = jnp.split(u, 3, axis=-1)
    z = (v * x1).astype(jnp.float32)
    filt = hyena_filters(L, f_w1, f_b1, f_freq, f_w2, f_b2, f_w3)
    hf = jnp.fft.rfft(filt, n=n, axis=0)
    hf = hf[:, :HY_WIDTH] + jnp.conj(hf[:, HY_WIDTH:])
    y = jnp.fft.irfft(jnp.fft.rfft(z, n=n, axis=1) * hf, n=n, axis=1)[:, :L]
    y = (y + z * f_bias.astype(jnp.float32)).astype(h.dtype) * x0
    return (y * jax.nn.silu(gate)) @ w_out


def axial_rope_angles(L):
    rows = L // GRID_W
    axis_dim = QK_ROPE // 2
    inv = ROPE_THETA ** (-jnp.arange(0, axis_dim, 2, dtype=jnp.float32) / axis_dim)
    row = jnp.repeat(jnp.arange(rows, dtype=jnp.float32), GRID_W)
    col = jnp.tile(jnp.arange(GRID_W, dtype=jnp.float32), rows)
    return row[:, None] * inv, col[:, None] * inv


def rope_1d(x, ang):
    half = x.shape[-1] // 2
    cos = jnp.cos(ang).astype(x.dtype)
    sin = jnp.sin(ang).astype(x.dtype)
    x1, x2 = x[..., :half], x[..., half:]
    return jnp.concatenate([x1 * cos - x2 * sin, x2 * cos + x1 * sin], axis=-1)


def apply_axial_rope(x, ang_r, ang_c):
    half = QK_ROPE // 2
    return jnp.concatenate([rope_1d(x[..., :half], ang_r), rope_1d(x[..., half:], ang_c)], axis=-1)


def mla_project(h, w_in, q_norm, w_qb, kv_norm):
    B, L, _ = h.shape
    proj = h @ w_in
    q_a, kv_a, k_pe, gate = jnp.split(
        proj, [Q_LORA, Q_LORA + KV_LORA, Q_LORA + KV_LORA + QK_ROPE], axis=-1)
    q = (rmsnorm(q_a, q_norm) @ w_qb).reshape(B, L, N_HEADS, QK_NOPE + QK_ROPE)
    ckv = rmsnorm(kv_a, kv_norm)
    return q[..., :QK_NOPE], q[..., QK_NOPE:], ckv, k_pe, gate


def mla_expand(ckv, w_kvb):
    B, L, _ = ckv.shape
    kv = (ckv @ w_kvb).reshape(B, L, N_HEADS, QK_NOPE + V_HEAD)
    return kv[..., :QK_NOPE], kv[..., QK_NOPE:]


def mla_attention(q_nope, q_pe, k_nope, k_pe, v):
    B, Lq = q_nope.shape[:2]
    nb = Lq // Q_BLOCK
    scale = 1.0 / math.sqrt(QK_NOPE + QK_ROPE)

    def to_blocks(t):
        return jnp.moveaxis(t.reshape(B, nb, Q_BLOCK, *t.shape[2:]), 1, 0)

    def block(args):
        qn, qp = args
        s = jnp.einsum('bqhd,bkhd->bhqk', qn, k_nope) + jnp.einsum('bqhr,bkr->bhqk', qp, k_pe)
        p = jax.nn.softmax(s.astype(jnp.float32) * scale, axis=-1).astype(v.dtype)
        return jnp.einsum('bhqk,bkhd->bqhd', p, v)

    o = lax.map(block, (to_blocks(q_nope), to_blocks(q_pe)))
    return jnp.moveaxis(o, 0, 1).reshape(B, Lq, N_HEADS * V_HEAD)


def mla_context(h, w_in, q_norm, w_qb, kv_norm, w_kvb, w_o):
    q_nope, q_pe, ckv, k_pe, gate = mla_project(h, w_in, q_norm, w_qb, kv_norm)
    k_nope, v = mla_expand(ckv, w_kvb)
    o = mla_attention(q_nope, q_pe, k_nope, k_pe, v)
    return (o * jax.nn.silu(gate)) @ w_o, ckv, k_pe


def mla_latent(h, ckv_ctx, kpe_ctx, w_in, q_norm, w_qb, kv_norm, w_kvb, w_o):
    L = h.shape[1]
    q_nope, q_pe, ckv, k_pe, gate = mla_project(h, w_in, q_norm, w_qb, kv_norm)
    ang_r, ang_c = axial_rope_angles(L)
    q_pe = apply_axial_rope(q_pe, ang_r[:, None, :], ang_c[:, None, :])
    k_pe = apply_axial_rope(k_pe, ang_r, ang_c)
    k_nope_l, v_l = mla_expand(ckv, w_kvb)
    k_nope_c, v_c = mla_expand(ckv_ctx, w_kvb)
    k_nope = jnp.concatenate([k_nope_l, k_nope_c], axis=1)
    k_pe_all = jnp.concatenate([k_pe, kpe_ctx], axis=1)
    v = jnp.concatenate([v_l, v_c], axis=1)
    o = mla_attention(q_nope, q_pe, k_nope, k_pe_all, v)
    return (o * jax.nn.silu(gate)) @ w_o


def setup_inputs(seed: int = 0) -> dict:
    key = jax.random.key(seed)
    ks = iter(jax.random.split(key, 40))
    f32 = jnp.float32

    def nrm(shape, s=1.0):
        return jax.random.normal(next(ks), shape, f32) * s

    D = D_MODEL
    return {
        'x_prompt': nrm((BATCH, SEQ, D)),
        'x_sample': nrm((DEC_BATCH, DEC_SEQ, D)),
        'cache_ckv': nrm((DEC_BATCH, N_MLA, PAST_LEN, KV_LORA)),
        'cache_kpe': nrm((DEC_BATCH, N_MLA, PAST_LEN, QK_ROPE)),
        'c': nrm((DEC_BATCH, D)),
        'c_ctx': nrm((D,)),
        'norm_w': 1.0 + nrm((DEPTH, D), 0.02),
        'ada_w': nrm((DEPTH, D, 3 * D), 0.5 * D ** -0.5),
        'ada_b': nrm((DEPTH, 3 * D), 0.02),
        'hy_w_in': nrm((N_HYENA, D, 4 * HY_WIDTH), D ** -0.5),
        'hy_conv_w': nrm((N_HYENA, SHORT_CONV, 3 * HY_WIDTH), 0.5),
        'hy_conv_b': nrm((N_HYENA, 3 * HY_WIDTH), 0.02),
        'hy_f_w1': nrm((N_HYENA, FILTER_EMB, FILTER_HIDDEN), FILTER_EMB ** -0.5),
        'hy_f_b1': nrm((N_HYENA, FILTER_HIDDEN), 0.02),
        'hy_f_freq': 1.0 + nrm((N_HYENA, FILTER_HIDDEN), 0.1),
        'hy_f_w2': nrm((N_HYENA, FILTER_HIDDEN, FILTER_HIDDEN), FILTER_HIDDEN ** -0.5),
        'hy_f_b2': nrm((N_HYENA, FILTER_HIDDEN), 0.02),
        'hy_f_w3': nrm((N_HYENA, FILTER_HIDDEN, 2 * HY_WIDTH), FILTER_HIDDEN ** -0.5),
        'hy_f_bias': nrm((N_HYENA, HY_WIDTH), 0.1),
        'hy_w_out': nrm((N_HYENA, HY_WIDTH, D), HY_WIDTH ** -0.5),
        'mla_w_in': nrm((N_MLA, D, MLA_IN), D ** -0.5),
        'mla_q_norm': 1.0 + nrm((N_MLA, Q_LORA), 0.02),
        'mla_w_qb': nrm((N_MLA, Q_LORA, N_HEADS * (QK_NOPE + QK_ROPE)), Q_LORA ** -0.5),
        'mla_kv_norm': 1.0 + nrm((N_MLA, KV_LORA), 0.02),
        'mla_w_kvb': nrm((N_MLA, KV_LORA, N_HEADS * (QK_NOPE + V_HEAD)), KV_LORA ** -0.5),
        'mla_w_o': nrm((N_MLA, N_HEADS * V_HEAD, D), (N_HEADS * V_HEAD) ** -0.5),
        'final_norm': 1.0 + nrm((D,), 0.02),
    }


def reference(x_prompt, x_sample, cache_ckv, cache_kpe, c, c_ctx, norm_w, ada_w, ada_b,
              hy_w_in, hy_conv_w, hy_conv_b, hy_f_w1, hy_f_b1, hy_f_freq, hy_f_w2, hy_f_b2,
              hy_f_w3, hy_f_bias, hy_w_out, mla_w_in, mla_q_norm, mla_w_qb, mla_kv_norm,
              mla_w_kvb, mla_w_o, final_norm):
    xp, xs = x_prompt, x_sample
    new_ckv, new_kpe = [], []
    for i in range(DEPTH):
        sh_p, sc_p, g_p = adaln(c_ctx[None, :], ada_w[i], ada_b[i])
        sh_s, sc_s, g_s = adaln(c, ada_w[i], ada_b[i])
        hp = rmsnorm(xp, norm_w[i]) * (1.0 + sc_p) + sh_p
        hs = rmsnorm(xs, norm_w[i]) * (1.0 + sc_s) + sh_s
        j = i // N_MIXERS
        if i % N_MIXERS == 0:
            hy = (hy_w_in[j], hy_conv_w[j], hy_conv_b[j], hy_f_w1[j], hy_f_b1[j], hy_f_freq[j],
                  hy_f_w2[j], hy_f_b2[j], hy_f_w3[j], hy_f_bias[j], hy_w_out[j])
            op = hyena_mix(hp, *hy)
            os_ = hyena_mix(hs, *hy)
        else:
            mla = (mla_w_in[j], mla_q_norm[j], mla_w_qb[j], mla_kv_norm[j], mla_w_kvb[j], mla_w_o[j])
            op, ckv, kpe = mla_context(hp, *mla)
            os_ = mla_latent(hs, cache_ckv[:, j], cache_kpe[:, j], *mla)
            new_ckv.append(ckv)
            new_kpe.append(kpe)
        xp = xp + g_p * op
        xs = xs + g_s * os_
    y_prompt = rmsnorm(xp, final_norm)
    y_sample = rmsnorm(xs, final_norm)
    state_ckv = jnp.stack(new_ckv, axis=1)
    state_kpe = jnp.stack(new_kpe, axis=1)
    return (y_prompt, y_sample, state_ckv, state_kpe)
```

```cpp
#include <hip/hip_runtime.h>
#include <hip/hip_cooperative_groups.h>
#include <cstdio>
#include <cstdint>
namespace cg = cooperative_groups;

typedef _Float16 f16;
typedef _Float16 f16x8 __attribute__((ext_vector_type(8)));
typedef _Float16 f16x4 __attribute__((ext_vector_type(4)));
typedef _Float16 f16x2 __attribute__((ext_vector_type(2)));
typedef float f32x4 __attribute__((ext_vector_type(4)));
typedef float f32x2 __attribute__((ext_vector_type(2)));

#define NTOK 8192
#define DM 1024
#define NKV 9216
#define MLA_IN 1696
#define MLA_INP 1792

struct Params {
  const float *x_prompt, *x_sample, *cache_ckv, *cache_kpe, *c, *c_ctx, *norm_w, *ada_w, *ada_b,
      *hy_w_in, *hy_conv_w, *hy_conv_b, *hy_f_w1, *hy_f_b1, *hy_f_freq, *hy_f_w2, *hy_f_b2, *hy_f_w3,
      *hy_f_bias, *hy_w_out, *mla_w_in, *mla_q_norm, *mla_w_qb, *mla_kv_norm, *mla_w_kvb, *mla_w_o,
      *final_norm;
  float* out;
  char* ws;
};

constexpr size_t MB = 1u << 20;
constexpr size_t OFF_X = 0;
constexpr size_t OFF_MOD = 32 * MB;
constexpr size_t OFF_HDN2 = OFF_MOD + 256 * 1024;
constexpr size_t OFF_FSUM = 34 * MB;
constexpr size_t OFF_H = 35 * MB;
constexpr size_t OFF_PROJ = 51 * MB;
constexpr size_t OFF_WHIN = 115 * MB;
constexpr size_t OFF_WHOUT = 131 * MB;
constexpr size_t OFF_WMIN = 135 * MB;
constexpr size_t OFF_WQB = 142 * MB;
constexpr size_t OFF_WKVB = 145 * MB;
constexpr size_t OFF_WO = 147 * MB;
constexpr size_t OFF_FRAW = 151 * MB;
constexpr size_t OFF_ZT = 187 * MB;
constexpr size_t OFF_MG = 203 * MB;
constexpr size_t OFF_YT = 219 * MB;
constexpr size_t OFF_A2 = 235 * MB;
constexpr size_t M_QN = 187 * MB;
constexpr size_t M_CKV = 193 * MB;
constexpr size_t M_KPEP = 198 * MB;
constexpr size_t M_KPES = 198 * MB + 512 * 1024;
constexpr size_t M_Q = 199 * MB;
constexpr size_t M_KNP = 223 * MB;
constexpr size_t M_KNS = 51 * MB + 28 * MB;
constexpr size_t M_VTP = 51 * MB + 38 * MB;
constexpr size_t M_VTS = 51 * MB + 46 * MB;
constexpr size_t OFF_BAR = 251 * MB;
constexpr size_t WS_NEED = 252 * MB;
constexpr int LDS_HALF = 8 * (512 * 16 + 64) + 128 * 80;
constexpr int LDS_BYTES = 2 * LDS_HALF;

__device__ __forceinline__ int opaque_int(int v) { asm volatile("" : "+s"(v)); return v; }
__device__ __forceinline__ int opaque_tid() { int t = threadIdx.x; asm volatile("" : "+v"(t)); return t & 255; }
__device__ __forceinline__ int opaque_tid512() { int t = threadIdx.x; asm volatile("" : "+v"(t)); return t; }
#define VBID ((int)(blockIdx.x * 2 + (opaque_tid512() >> 8)))
#define VGRID ((int)(gridDim.x * 2))
__device__ __forceinline__ float silu_f(float x) { return x / (1.f + __expf(-x)); }
__device__ __forceinline__ float wave_sum(float v) {
#pragma unroll
  for (int o = 32; o > 0; o >>= 1) v += __shfl_xor(v, o);
  return v;
}
__device__ __forceinline__ int tok_cond(int tok) { return tok < 4096 ? 0 : 1 + ((tok - 4096) >> 11); }

typedef __fp16 h16x4_t __attribute__((__vector_size__(4 * sizeof(__fp16))));
__device__ __forceinline__ f16x4 lds_tr_read(const char* lds_ptr) {
  h16x4_t v = __builtin_amdgcn_ds_read_tr16_b64_v4f16((__attribute__((address_space(3))) h16x4_t*)(unsigned)(size_t)lds_ptr);
  f16x4 r;
  __builtin_memcpy(&r, &v, 8);
  return r;
}
template <int SWAP, int NT, int ATR, int APERM, int ASTAT, class Epi>
__device__ __forceinline__ void gemm512(const f16* __restrict__ A, int lda, const f16* __restrict__ Bt, int ldb, int K,
                                        int tilesM, int ntiles, int first, int stride, char* smem, Epi epi,
                                        const f16* __restrict__ A2nd = nullptr, int lda2 = 0, int tmSplit = 1 << 30) {
  constexpr int BN = 64 * NT, BCH = BN / 64, BUF = 32768 + BN * 128;
  const int cnt = first < ntiles ? (ntiles - first + stride - 1) / stride : 0;
  if (cnt == 0) return;
  const int tid = opaque_tid512(), wid = tid >> 6, lane = tid & 63, wr = wid >> 2, wc = wid & 3, fr = lane & 15,
            fq = lane >> 4;
  const int srow = tid >> 3, sc = tid & 7;
  const int woff = srow * 128 + ((sc ^ ((srow >> 1) & 7)) * 16);
  const int fsw = (fr >> 1) & 7;
  constexpr int GSH = NT == 4 ? 4 : 3;
  const int woffB = SWAP ? srow * 128 + ((sc ^ ((((srow >> GSH) & 3) << 1) | ((srow >> 1) & 1))) * 16) : woff;
  const int browl = SWAP ? wc * 16 * NT + (fr >> 2) * 4 * NT + (fr & 3) : wc * 16 * NT + fr;
  const int fswB = SWAP ? (((fr >> 2) & 3) << 1) | ((fr >> 1) & 1) : fsw;
  const int aoff = APERM ? (wr * 128 + (fr >> 2) * 8 + (fr & 3)) * 128 : (wr * 128 + fr) * 128;
  const int fswA = APERM ? ((((fr >> 2) & 3) << 1) | ((fr >> 1) & 1)) : fsw;
  const int boff = 32768 + browl * 128;
  const int skr = tid >> 5, smc = tid & 31;
  const int woffT = skr * 512 + ((smc ^ (2 * ((skr & 3) | (((skr >> 3) & 1) << 2)))) * 16);
  const int trq = (lane & 15) >> 2, trp = lane & 3;
  const int nk = K >> 6, total = cnt * nk;
  f32x4 acc[8][NT];
  f16x8 pa[4], pb[BCH];
  float ssq[4] = {0.f, 0.f, 0.f, 0.f};
  float* rstdS = reinterpret_cast<float*>(smem + 2 * BUF);
#define G5_ISSUE(S_)                                                                          \
  {                                                                                           \
    const int i_ = (S_) / nk, k_ = (S_) - i_ * nk, t_ = first + i_ * stride;                  \
    const int tm_ = t_ % tilesM;                                                              \
    const bool second_ = !ATR && tm_ >= tmSplit;             \
    const int ldq_ = second_ ? lda2 : lda;                                                    \
    const f16* abase_ = second_ ? A2nd + (size_t)(tm_ - tmSplit) * 256 * lda2 : A + (size_t)tm_ * 256 * lda; \
    const f16* ag_ = ATR ? A + (size_t)(k_ * 64 + (tid >> 5)) * lda + (t_ % tilesM) * 256 + (tid & 31) * 8      \
                         : abase_ + (size_t)srow * ldq_ + sc * 8 + k_ * 64;                                     \
    const f16* bg_ = Bt + (size_t)((t_ / tilesM) * BN + srow) * ldb + sc * 8 + k_ * 64;      \
    _Pragma("unroll") for (int q_ = 0; q_ < 4; ++q_) pa[q_] = *reinterpret_cast<const f16x8*>(ag_ + (size_t)((ATR ? 16 : 64) * q_) * ldq_); \
    _Pragma("unroll") for (int q_ = 0; q_ < BCH; ++q_) pb[q_] = *reinterpret_cast<const f16x8*>(bg_ + (size_t)(64 * q_) * ldb); \
  }
#define G5_STORE(BUFI_)                                                                       \
  {                                                                                           \
    char* nb_ = smem + (BUFI_) * BUF;                                                         \
    if (ASTAT) {                                                                              \
      _Pragma("unroll") for (int q_ = 0; q_ < 4; ++q_)                                        \
        _Pragma("unroll") for (int e_ = 0; e_ < 8; e_ += 2) {                                 \
          const f16x2 a_ = {pa[q_][e_], pa[q_][e_ + 1]};                                      \
          ssq[q_] = __builtin_amdgcn_fdot2(a_, a_, ssq[q_], false);                           \
        }                                                                                     \
    }                                                                                         \
    _Pragma("unroll") for (int q_ = 0; q_ < 4; ++q_) *reinterpret_cast<f16x8*>(nb_ + (ATR ? woffT : APERM ? srow * 128 + ((sc ^ ((((srow >> 3) & 3) << 1) | ((srow >> 1) & 1))) * 16) : woff) + q_ * 8192) = pa[q_]; \
    _Pragma("unroll") for (int q_ = 0; q_ < BCH; ++q_) *reinterpret_cast<f16x8*>(nb_ + 32768 + woffB + q_ * 8192) = pb[q_]; \
  }
  G5_ISSUE(0)
  G5_STORE(0)
  __syncthreads();
  for (int s = 0; s < total; ++s) {
    if (s + 1 < total) G5_ISSUE(s + 1)
    const int ti = s / nk, kk = s - ti * nk;
    if (kk == 0) {
#pragma unroll
      for (int m = 0; m < 8; ++m)
#pragma unroll
        for (int n = 0; n < NT; ++n) acc[m][n] = f32x4{0.f, 0.f, 0.f, 0.f};
    }
    const char* buf = smem + (s & 1) * BUF;
    if (NT == 2) {
    f16x8 afA[4], afB[4], bfA[NT];
#define G5_READ_A(DST, KS_, MH_)                                                                                   \
    {                                                                                                              \
      if (ATR) {                                                                                                   \
        _Pragma("unroll") for (int m4 = 0; m4 < 4; ++m4) {                                                         \
          const int m = (MH_) * 4 + m4;                                                                            \
          f16x4 h2[2];                                                                                             \
          _Pragma("unroll") for (int t2 = 0; t2 < 2; ++t2) {                                                       \
            const int krow = 32 * (KS_) + 8 * fq + 4 * t2 + trq;                                                   \
            const int ch = ((wr * 128 + m * 16 + 4 * trp) >> 3) ^ (2 * ((krow & 3) | (((krow >> 3) & 1) << 2)));   \
            h2[t2] = lds_tr_read(buf + krow * 512 + ch * 16 + 8 * (trp & 1));                                      \
          }                                                                                                        \
          DST[m4] = f16x8{h2[0][0], h2[0][1], h2[0][2], h2[0][3], h2[1][0], h2[1][1], h2[1][2], h2[1][3]};          \
        }                                                                                                          \
      } else {                                                                                                     \
        const int coA = ((((KS_) * 4 + fq) ^ fswA) * 16);                                                          \
        _Pragma("unroll") for (int m4 = 0; m4 < 4; ++m4) {                                                         \
          const int m = (MH_) * 4 + m4;                                                                            \
          DST[m4] = *reinterpret_cast<const f16x8*>(buf + aoff + (APERM ? (m >> 1) * 4096 + (m & 1) * 512 : m * 2048) + coA); \
        }                                                                                                          \
      }                                                                                                            \
    }
#define G5_READ_B(DST, KS_)                                                                                        \
    {                                                                                                              \
      const int coB = ((((KS_) * 4 + fq) ^ fswB) * 16);                                                            \
      _Pragma("unroll") for (int n = 0; n < NT; ++n) DST[n] = *reinterpret_cast<const f16x8*>(buf + boff + n * (SWAP ? 512 : 2048) + coB); \
    }
#define G5_MMA(AF, BF, MH_)                                                                                        \
    {                                                                                                              \
      _Pragma("unroll") for (int m4 = 0; m4 < 4; ++m4) _Pragma("unroll") for (int n = 0; n < NT; ++n) {            \
        const int m = (MH_) * 4 + m4;                                                                              \
        if (SWAP) acc[m][n] = __builtin_amdgcn_mfma_f32_16x16x32_f16(BF[n], AF[m4], acc[m][n], 0, 0, 0);           \
        else acc[m][n] = __builtin_amdgcn_mfma_f32_16x16x32_f16(AF[m4], BF[n], acc[m][n], 0, 0, 0);                \
      }                                                                                                            \
    }
    G5_READ_B(bfA, 0)
    G5_READ_A(afA, 0, 0)
    __builtin_amdgcn_sched_barrier(0);
    G5_READ_A(afB, 0, 1)
    __builtin_amdgcn_sched_barrier(0);
    G5_MMA(afA, bfA, 0)
    __builtin_amdgcn_sched_barrier(0);
    G5_READ_A(afA, 1, 0)
    __builtin_amdgcn_sched_barrier(0);
    G5_MMA(afB, bfA, 1)
    __builtin_amdgcn_sched_barrier(0);
    G5_READ_B(bfA, 1)
    G5_READ_A(afB, 1, 1)
    __builtin_amdgcn_sched_barrier(0);
    G5_MMA(afA, bfA, 0)
    __builtin_amdgcn_sched_barrier(0);
    G5_MMA(afB, bfA, 1)
    __builtin_amdgcn_sched_barrier(0);
#undef G5_READ_A
#undef G5_READ_B
#undef G5_MMA
    } else {
#pragma unroll
    for (int ks = 0; ks < 2; ++ks) {
      f16x8 af[4], bf[NT];
      const int co = (((ks * 4 + fq) ^ fsw) * 16);
      const int coB = (((ks * 4 + fq) ^ fswB) * 16);
#pragma unroll
      for (int n = 0; n < NT; ++n) bf[n] = *reinterpret_cast<const f16x8*>(buf + boff + n * (SWAP ? 512 : 2048) + coB);
#pragma unroll
      for (int mh = 0; mh < 2; ++mh) {
        if (ATR) {
#pragma unroll
          for (int m4 = 0; m4 < 4; ++m4) {
            const int m = mh * 4 + m4;
            f16x4 h2[2];
#pragma unroll
            for (int t2 = 0; t2 < 2; ++t2) {
              const int krow = 32 * ks + 8 * fq + 4 * t2 + trq;
              const int ch = ((wr * 128 + m * 16 + 4 * trp) >> 3) ^ (2 * ((krow & 3) | (((krow >> 3) & 1) << 2)));
              h2[t2] = lds_tr_read(buf + krow * 512 + ch * 16 + 8 * (trp & 1));
            }
            af[m4] = f16x8{h2[0][0], h2[0][1], h2[0][2], h2[0][3], h2[1][0], h2[1][1], h2[1][2], h2[1][3]};
          }
        } else {
          const int coA = (((ks * 4 + fq) ^ fswA) * 16);
#pragma unroll
          for (int m4 = 0; m4 < 4; ++m4) {
            const int m = mh * 4 + m4;
            af[m4] = *reinterpret_cast<const f16x8*>(buf + aoff + (APERM ? (m >> 1) * 4096 + (m & 1) * 512 : m * 2048) + coA);
          }
        }
        __builtin_amdgcn_sched_barrier(0);
#pragma unroll
        for (int m4 = 0; m4 < 4; ++m4)
#pragma unroll
          for (int n = 0; n < NT; ++n) {
            const int m = mh * 4 + m4;
            if (SWAP) acc[m][n] = __builtin_amdgcn_mfma_f32_16x16x32_f16(bf[n], af[m4], acc[m][n], 0, 0, 0);
            else acc[m][n] = __builtin_amdgcn_mfma_f32_16x16x32_f16(af[m4], bf[n], acc[m][n], 0, 0, 0);
          }
        __builtin_amdgcn_sched_barrier(0);
      }
    }
    }
    if (ASTAT && kk == nk - 1) {
      const int t_ = first + ti * stride;
      const bool cacheRows = (t_ % tilesM) >= tmSplit;
#pragma unroll
      for (int q = 0; q < 4; ++q) {
        float v = ssq[q];
        v += __shfl_xor(v, 1); v += __shfl_xor(v, 2); v += __shfl_xor(v, 4);
        if (sc == 0) rstdS[srow + 64 * q] = cacheRows ? 1.f : rsqrtf(v / (float)K + 1e-6f);
        ssq[q] = 0.f;
      }
    }
    if (s + 1 < total) G5_STORE((s + 1) & 1)
    __syncthreads();
    if (kk == nk - 1) {
      const int t_ = first + ti * stride;
      const int brow = (t_ % tilesM) * 256, bcol = (t_ / tilesM) * BN;
      if (APERM) {
#pragma unroll
        for (int n = 0; n < NT; ++n) {
          f32x4 cv[8];
#pragma unroll
          for (int m = 0; m < 8; ++m) cv[m] = acc[m][n];
          epi.colT(bcol + wc * 16 * NT + n * 16 + fr, brow + wr * 128 + fq * 8, cv);
        }
      } else if (SWAP) {
#pragma unroll
        for (int m = 0; m < 8; ++m) epi.row(brow + wr * 128 + m * 16 + fr, bcol + wc * 16 * NT + fq * 4 * NT, acc[m]);
      } else {
#pragma unroll
        for (int m = 0; m < 8; ++m)
#pragma unroll
          for (int n = 0; n < NT; ++n) epi(brow + wr * 128 + m * 16, bcol + wc * 16 * NT + n * 16, fr, fq, acc[m][n]);
      }
    }
  }
#undef G5_ISSUE
#undef G5_STORE
}

__device__ __forceinline__ void convert_tile(const float* __restrict__ src, f16* __restrict__ dst, int K, int N, int tile,
                             char* smem, const float* __restrict__ kscale = nullptr) {
  f16(*T)[72] = reinterpret_cast<f16(*)[72]>(smem);
  const int tid = opaque_tid();
  const int nkt = K >> 6;
  const int k0 = (tile % nkt) * 64, n0 = (tile / nkt) * 64;
  const int kk = tid >> 4, nn4 = (tid & 15) * 4;
#pragma unroll
  for (int i = 0; i < 4; ++i) {
    int k = k0 + kk + 16 * i, n = n0 + nn4;
    float4 v = make_float4(0.f, 0.f, 0.f, 0.f);
    if (n < N) {
      const float* sp_ = src + (size_t)k * N + n;
      v.x = __builtin_nontemporal_load(sp_); v.y = __builtin_nontemporal_load(sp_ + 1);
      v.z = __builtin_nontemporal_load(sp_ + 2); v.w = __builtin_nontemporal_load(sp_ + 3);
    }
    if (kscale) { const float g = kscale[k]; v.x *= g; v.y *= g; v.z *= g; v.w *= g; }
    T[nn4 + 0][kk + 16 * i] = (f16)v.x;
    T[nn4 + 1][kk + 16 * i] = (f16)v.y;
    T[nn4 + 2][kk + 16 * i] = (f16)v.z;
    T[nn4 + 3][kk + 16 * i] = (f16)v.w;
  }
  __syncthreads();
  const int n = tid >> 2, ks = (tid & 3) * 16;
  f16* d = dst + (size_t)(n0 + n) * K + k0 + ks;
  *reinterpret_cast<f16x8*>(d) = *reinterpret_cast<const f16x8*>(&T[n][ks]);
  *reinterpret_cast<f16x8*>(d + 8) = *reinterpret_cast<const f16x8*>(&T[n][ks + 8]);
  __syncthreads();
}

__device__ __forceinline__ void ada_tile(const Params& p, int tile, char* smem) {
  float* s = reinterpret_cast<float*>(smem);
  float* red = s + 3072;
  const int tid = opaque_tid();
  const int layer = tile / 96, cgp = tile % 96;
  for (int i = tid; i < 3072; i += 256) {
    int cnd = i >> 10, k = i & 1023;
    float v = cnd == 0 ? p.c_ctx[k] : p.c[(cnd - 1) * 1024 + k];
    s[i] = silu_f(v);
  }
  __syncthreads();
  const int cq = tid & 7, kg = tid >> 3;
  const float* W = p.ada_w + (size_t)layer * 1024 * 3072 + cgp * 32 + cq * 4;
  float4 a0 = make_float4(0.f, 0.f, 0.f, 0.f), a1 = a0, a2 = a0;
#pragma unroll 8
  for (int k = kg * 32; k < kg * 32 + 32; ++k) {
    const float* wp_ = W + (size_t)k * 3072;
    const float4 w = make_float4(__builtin_nontemporal_load(wp_), __builtin_nontemporal_load(wp_ + 1), __builtin_nontemporal_load(wp_ + 2), __builtin_nontemporal_load(wp_ + 3));
    const float s0 = s[k], s1 = s[1024 + k], s2 = s[2048 + k];
    a0.x += s0 * w.x; a0.y += s0 * w.y; a0.z += s0 * w.z; a0.w += s0 * w.w;
    a1.x += s1 * w.x; a1.y += s1 * w.y; a1.z += s1 * w.z; a1.w += s1 * w.w;
    a2.x += s2 * w.x; a2.y += s2 * w.y; a2.z += s2 * w.z; a2.w += s2 * w.w;
  }
  *reinterpret_cast<float4*>(red + (kg * 3 + 0) * 32 + cq * 4) = a0;
  *reinterpret_cast<float4*>(red + (kg * 3 + 1) * 32 + cq * 4) = a1;
  *reinterpret_cast<float4*>(red + (kg * 3 + 2) * 32 + cq * 4) = a2;
  __syncthreads();
  if (tid < 96) {
    const int cnd = tid >> 5, c2 = tid & 31;
    float v = p.ada_b[layer * 3072 + cgp * 32 + c2];
#pragma unroll
    for (int q = 0; q < 32; ++q) v += red[(q * 3 + cnd) * 32 + c2];
    reinterpret_cast<float*>(p.ws + OFF_MOD)[(layer * 3 + cnd) * 3072 + cgp * 32 + c2] = v;
  }
  __syncthreads();
}

__device__ __forceinline__ void hidden_tile(const Params& p, int tile, char* smem) {
  float* z = reinterpret_cast<float*>(smem);
  float* h1 = z + 4 * 36;
  const int tid = opaque_tid(), w = tid >> 6, o = tid & 63;
  const int j = tile / 576, r = (tile % 576) * 4 + w;
  const int L = r < 256 ? 256 : 2048, ti = r < 256 ? r : r - 256;
  if (o < 33) {
    float v;
    if (o == 0) {
      v = (float)ti / (float)(L - 1);
    } else {
      int bi = (o - 1) & 15;
      float band = 1e-4f + (float)bi * ((15.0f - 1e-4f) / 15.0f);
      float wang = (6.283185307179586f / (float)L) * (float)ti;
      float ang = band * wang;
      v = (o <= 16) ? cosf(ang) : -sinf(ang);
    }
    z[w * 36 + o] = v;
  }
  __syncthreads();
  const float fr = p.hy_f_freq[j * 64 + o];
  float a = p.hy_f_b1[j * 64 + o];
  for (int e = 0; e < 33; ++e) a += z[w * 36 + e] * p.hy_f_w1[(j * 33 + e) * 64 + o];
  h1[w * 64 + o] = sinf(fr * a);
  __syncthreads();
  a = p.hy_f_b2[j * 64 + o];
  for (int k = 0; k < 64; ++k) a += h1[w * 64 + k] * p.hy_f_w2[(j * 64 + k) * 64 + o];
  reinterpret_cast<float*>(p.ws + OFF_HDN2)[((size_t)j * 2304 + r) * 64 + o] = sinf(fr * a);
  __syncthreads();
}

__device__ __forceinline__ void phase0(const Params& p, char* smem) {
  const int T_ADA = 96, T_HID = 1152, T_XC = 0, T_CV = 4512;
  const int total = T_ADA + T_HID + T_XC + T_CV;
  for (int t = VBID; t < total; t += VGRID) {
    if (t < T_ADA) {
      ada_tile(p, t, smem);
    } else if (t < T_ADA + T_HID) {
      hidden_tile(p, t - T_ADA, smem);
    } else if (t < T_ADA + T_HID + T_XC) {
      int tt = t - T_ADA - T_HID;
      float4* X = reinterpret_cast<float4*>(p.ws + OFF_X);
#pragma unroll
      for (int i = 0; i < 4; ++i) {
        size_t idx = (size_t)tt * 1024 + i * 256 + (threadIdx.x & 255);
        const float4* src = idx < (1u << 20) ? reinterpret_cast<const float4*>(p.x_prompt) + idx
                                             : reinterpret_cast<const float4*>(p.x_sample) + (idx - (1u << 20));
        X[idx] = *src;
      }
      __syncthreads(); __syncthreads(); __syncthreads();
    } else {
      int tt = t - T_ADA - T_HID - T_XC;
      const int j = tt / 2256;
      int u = tt % 2256;
      if (u < 1024) {
        convert_tile(p.hy_w_in + (size_t)j * 1024 * 4096, reinterpret_cast<f16*>(p.ws + OFF_WHIN) + (size_t)j * 4096 * 1024, 1024, 4096, u, smem);
      } else if (u < 1280) {
        convert_tile(p.hy_w_out + (size_t)j * 1024 * 1024, reinterpret_cast<f16*>(p.ws + OFF_WHOUT) + (size_t)j * 1024 * 1024, 1024, 1024, u - 1024, smem);
      } else if (u < 1728) {
        convert_tile(p.mla_w_in + (size_t)j * 1024 * MLA_IN, reinterpret_cast<f16*>(p.ws + OFF_WMIN) + (size_t)j * MLA_INP * 1024, 1024, MLA_IN, u - 1280, smem);
      } else if (u < 1872) {
        convert_tile(p.mla_w_qb + (size_t)j * 384 * 1536, reinterpret_cast<f16*>(p.ws + OFF_WQB) + (size_t)j * 1536 * 384, 384, 1536, u - 1728, smem, p.mla_q_norm + j * 384);
      } else if (u < 2000) {
        convert_tile(p.mla_w_kvb + (size_t)j * 256 * 2048, reinterpret_cast<f16*>(p.ws + OFF_WKVB) + (size_t)j * 2048 * 256, 256, 2048, u - 1872, smem, p.mla_kv_norm + j * 256);
      } else {
        convert_tile(p.mla_w_o + (size_t)j * 1024 * 1024, reinterpret_cast<f16*>(p.ws + OFF_WO) + (size_t)j * 1024 * 1024, 1024, 1024, u - 2000, smem);
      }
      __syncthreads();
    }
  }
}

typedef float f32x16 __attribute__((ext_vector_type(16)));
__device__ __forceinline__ void phase1(const Params& p, char* smem) {
  float* red = reinterpret_cast<float*>(smem);
  const int tid = opaque_tid(), w = tid >> 6, lane = tid & 63, r = lane & 31, hh = lane >> 5;
  const float* HD = reinterpret_cast<const float*>(p.ws + OFF_HDN2);
  float* G2 = reinterpret_cast<float*>(p.ws + OFF_FRAW);
  float* G1 = G2 + (size_t)2 * 1024 * 4096;
  float* FSUM = reinterpret_cast<float*>(p.ws + OFF_FSUM);
  for (int t = VGRID - 1 - VBID; t < 576; t += VGRID) {
    const int j = t / 288, u = t % 288, tch = u >> 5, cgp = u & 31;
    const int L = tch == 0 ? 256 : 2048;
    const int ti0 = (tch == 0 ? 0 : (tch - 1) * 256) + w * 64;
    const int row0 = (tch == 0 ? 0 : 256) + ti0;
    f16x8 af[2][4], bf[2][4];
#pragma unroll
    for (int rt = 0; rt < 2; ++rt)
#pragma unroll
      for (int ks = 0; ks < 4; ++ks) {
        const float* ap = HD + ((size_t)j * 2304 + row0 + rt * 32 + r) * 64 + ks * 16 + hh * 8;
        const float4 x0 = *reinterpret_cast<const float4*>(ap), x1 = *reinterpret_cast<const float4*>(ap + 4);
        af[rt][ks] = f16x8{(f16)x0.x, (f16)x0.y, (f16)x0.z, (f16)x0.w, (f16)x1.x, (f16)x1.y, (f16)x1.z, (f16)x1.w};
      }
#pragma unroll
    for (int ct = 0; ct < 2; ++ct)
#pragma unroll
      for (int ks = 0; ks < 4; ++ks)
#pragma unroll
        for (int jj = 0; jj < 8; ++jj)
          bf[ct][ks][jj] = (f16)p.hy_f_w3[((size_t)j * 64 + ks * 16 + hh * 8 + jj) * 2048 + cgp * 64 + ct * 32 + r];
    f32x16 acc[2][2];
#pragma unroll
    for (int rt = 0; rt < 2; ++rt)
#pragma unroll
      for (int ct = 0; ct < 2; ++ct) {
#pragma unroll
        for (int q = 0; q < 16; ++q) acc[rt][ct][q] = 0.f;
#pragma unroll
        for (int ks = 0; ks < 4; ++ks) acc[rt][ct] = __builtin_amdgcn_mfma_f32_32x32x16_f16(af[rt][ks], bf[ct][ks], acc[rt][ct], 0, 0, 0);
      }
    const float min_decay = -3.0701134573253945f, max_decay = -15.350567286626973f;
    const float invLm1 = 1.0f / (float)(L - 1);
#pragma unroll
    for (int ct = 0; ct < 2; ++ct) {
      const int col = cgp * 64 + ct * 32 + r, c = col & 1023;
      const bool fwd = col < 1024;
      const float delta = fabsf(min_decay + (float)c * ((max_decay - min_decay) / 1023.0f));
      float* Gc = L == 2048 ? G2 + ((size_t)j * 1024 + c) * 4096 : G1 + ((size_t)j * 1024 + c) * 512;
      float sa = 0.f;
#pragma unroll
      for (int rt = 0; rt < 2; ++rt)
#pragma unroll
        for (int g4 = 0; g4 < 4; ++g4) {
          const int tib = ti0 + rt * 32 + 8 * g4 + 4 * hh;
          float hv[4];
#pragma unroll
          for (int q = 0; q < 4; ++q) {
            const float tt = (float)(tib + q) * invLm1;
            hv[q] = acc[rt][ct][g4 * 4 + q] * __expf(-tt * delta);
            sa += fabsf(hv[q]);
          }
          if (fwd) {
            *reinterpret_cast<float4*>(Gc + L + tib) = make_float4(hv[0], hv[1], hv[2], hv[3]);
          } else {
#pragma unroll
            for (int q = 0; q < 4; ++q) { const int ti = tib + q; Gc[ti == 0 ? 0 : L - ti] = hv[q]; }
          }
        }
      sa += __shfl_xor(sa, 32);
      if (hh == 0) red[w * 64 + ct * 32 + r] = sa;
    }
    __syncthreads();
    if (tid < 64) FSUM[((size_t)j * 9 + tch) * 2048 + cgp * 64 + tid] = red[tid] + red[64 + tid] + red[128 + tid] + red[192 + tid];
    __syncthreads();
  }
}

__device__ __forceinline__ void phase_norm(const Params& p, int layer) {
  const int tid = opaque_tid(), w = tid >> 6, lane = tid & 63;
  const float4* X = reinterpret_cast<const float4*>(p.ws + OFF_X);
  const float* MOD = reinterpret_cast<const float*>(p.ws + OFF_MOD);
  f16* H = reinterpret_cast<f16*>(p.ws + OFF_H);
  const float4* nw = reinterpret_cast<const float4*>(p.norm_w + layer * 1024);
  for (int t = VBID; t < 2048; t += VGRID) {
    const int row = t * 4 + w;
    const int cnd = tok_cond(row);
    const float4* xr = X + (size_t)row * 256;
    if (layer == 0) xr = row < 4096 ? reinterpret_cast<const float4*>(p.x_prompt) + (size_t)row * 256
                                    : reinterpret_cast<const float4*>(p.x_sample) + (size_t)(row - 4096) * 256;
    const float4* sh = reinterpret_cast<const float4*>(MOD + (layer * 3 + cnd) * 3072);
    const float4* sc = sh + 256;
    float4 v[4];
    float ss = 0.f;
#pragma unroll
    for (int i = 0; i < 4; ++i) {
      v[i] = xr[lane + 64 * i];
      ss += v[i].x * v[i].x + v[i].y * v[i].y + v[i].z * v[i].z + v[i].w * v[i].w;
    }
    ss = wave_sum(ss);
    const float rstd = rsqrtf(ss * (1.f / 1024.f) + 1e-6f);
#pragma unroll
    for (int i = 0; i < 4; ++i) {
      const int q = lane + 64 * i;
      float4 g = nw[q], a = sc[q], b = sh[q];
      f16x4 o;
      o[0] = (f16)(v[i].x * rstd * g.x * (1.f + a.x) + b.x);
      o[1] = (f16)(v[i].y * rstd * g.y * (1.f + a.y) + b.y);
      o[2] = (f16)(v[i].z * rstd * g.z * (1.f + a.z) + b.z);
      o[3] = (f16)(v[i].w * rstd * g.w * (1.f + a.w) + b.w);
      *reinterpret_cast<f16x4*>(H + (size_t)row * 1024 + q * 4) = o;
    }
  }
}

struct EpiStoreF16 {
  f16* C; int ldc; int N; float scale; const float* rstdS = nullptr;
  __device__ __forceinline__ void colT(int, int, const f32x4 (&)[8]) const {}
  template <int NT>
  __device__ __forceinline__ void row(int row, int col0, const f32x4 (&v)[NT]) const {
    if (col0 < N) {
      const float sc_ = rstdS ? scale * rstdS[row & 255] : scale;
#pragma unroll
      for (int h = 0; h < NT / 2; ++h) {
        f16x8 o;
#pragma unroll
        for (int q = 0; q < 4; ++q) { o[q] = (f16)(v[2 * h][q] * sc_); o[4 + q] = (f16)(v[2 * h + 1][q] * sc_); }
        *reinterpret_cast<f16x8*>(C + (size_t)row * ldc + col0 + 8 * h) = o;
      }
    }
  }
  __device__ __forceinline__ void operator()(int rb, int cb, int fr, int fq, f32x4 a) const {
    int row = rb + fr, col = cb + fq * 4;
    if (col < N) {
      f16x4 o;
      o[0] = (f16)(a[0] * scale); o[1] = (f16)(a[1] * scale); o[2] = (f16)(a[2] * scale); o[3] = (f16)(a[3] * scale);
      *reinterpret_cast<f16x4*>(C + (size_t)row * ldc + col) = o;
    }
  }
};
struct EpiResid {
  float* X; const float* MODL;
  const float* srcP; const float* srcS;
  __device__ __forceinline__ void colT(int, int, const f32x4 (&)[8]) const {}
  template <int NT>
  __device__ __forceinline__ void row(int row, int col0, const f32x4 (&v)[NT]) const {
    const float* gp = MODL + tok_cond(row) * 3072 + 2048 + col0;
    float* xp = X + (size_t)row * 1024 + col0;
    const float* sp = row < 4096 ? srcP + (size_t)row * 1024 + col0 : srcS + (size_t)(row - 4096) * 1024 + col0;
#pragma unroll
    for (int n = 0; n < NT; ++n) {
      const float4 g = *reinterpret_cast<const float4*>(gp + 4 * n);
      const f32x4 xl_ = __builtin_nontemporal_load(reinterpret_cast<const f32x4*>(sp + 4 * n));
      float4 x = make_float4(xl_[0], xl_[1], xl_[2], xl_[3]);
      x.x += g.x * v[n][0]; x.y += g.y * v[n][1]; x.z += g.z * v[n][2]; x.w += g.w * v[n][3];
      *reinterpret_cast<float4*>(xp + 4 * n) = x;
    }
  }
  __device__ __forceinline__ void operator()(int rb, int cb, int fr, int fq, f32x4 a) const {
    int row = rb + fr, col = cb + fq * 4;
    const float4 g = *reinterpret_cast<const float4*>(MODL + tok_cond(row) * 3072 + 2048 + col);
    float4* xp = reinterpret_cast<float4*>(X + (size_t)row * 1024 + col);
    const float* sp = row < 4096 ? srcP + (size_t)row * 1024 + col : srcS + (size_t)(row - 4096) * 1024 + col;
    float4 x = *reinterpret_cast<const float4*>(sp);
    x.x += g.x * a[0]; x.y += g.y * a[1]; x.z += g.z * a[2]; x.w += g.w * a[3];
    *xp = x;
  }
};
struct EpiStoreT {
  f16* CT; int ldt;
  __device__ __forceinline__ void colT(int col, int t0, const f32x4 (&v)[8]) const {
#pragma unroll
    for (int h = 0; h < 4; ++h) {
      f16x8 o;
#pragma unroll
      for (int q = 0; q < 4; ++q) { o[q] = (f16)v[2 * h][q]; o[4 + q] = (f16)v[2 * h + 1][q]; }
      *reinterpret_cast<f16x8*>(CT + (size_t)col * ldt + t0 + 32 * h) = o;
    }
  }
  template <int NT>
  __device__ __forceinline__ void row(int, int, const f32x4 (&)[NT]) const {}
  __device__ __forceinline__ void operator()(int, int, int, int, f32x4) const {}
};
struct EpiNull {
  __device__ __forceinline__ void colT(int, int, const f32x4 (&)[8]) const {}
  template <int NT>
  __device__ __forceinline__ void row(int row, int col0, const f32x4 (&v)[NT]) const {
#pragma unroll
    for (int n = 0; n < NT; ++n) asm volatile("" :: "v"(v[n][0]), "v"(v[n][1]), "v"(v[n][2]), "v"(v[n][3]));
  }
  __device__ __forceinline__ void operator()(int rb, int cb, int fr, int fq, f32x4 a) const { asm volatile("" :: "v"(a[0]), "v"(a[1]), "v"(a[2]), "v"(a[3])); }
};
struct EpiKV {
  char* ws; const float* rstdS;
  __device__ __forceinline__ void colT(int, int, const f32x4 (&)[8]) const {}
  template <int NT>
  __device__ __forceinline__ void row(int, int, const f32x4 (&)[NT]) const {}
  __device__ __forceinline__ void operator()(int rb, int cb, int fr, int fq, f32x4 a) const {
    const int r0 = rb + fq * 4, n = cb + fr;
    const int h = n >> 7, e = n & 127;
    int b, key;
    const bool pr = r0 < 4096;
    if (pr) { b = r0 >> 8; key = r0 & 255; }
    else if (r0 < 8192) { b = (r0 - 4096) >> 11; key = (r0 - 4096) & 2047; }
    else { b = (r0 - 8192) >> 9; key = 2048 + ((r0 - 8192) & 511); }
    const size_t Lk = pr ? 256 : 2560;
    const size_t bh = (size_t)b * 16 + h;
    const f32x4 rs = *reinterpret_cast<const f32x4*>(rstdS + (r0 & 255));
    a = a * rs;
    if (e < 64) {
      f16* KN = reinterpret_cast<f16*>(ws + (pr ? M_KNP : M_KNS));
#pragma unroll
      for (int j = 0; j < 4; ++j) KN[(bh * Lk + key + j) * 64 + e] = (f16)a[j];
    } else {
      f16* VT = reinterpret_cast<f16*>(ws + (pr ? M_VTP : M_VTS));
      f16x4 o;
      o[0] = (f16)a[0]; o[1] = (f16)a[1]; o[2] = (f16)a[2]; o[3] = (f16)a[3];
      *reinterpret_cast<f16x4*>(VT + (bh * 64 + (e - 64)) * Lk + key) = o;
    }
  }
};

__device__ __forceinline__ void hy_u8(const f16* __restrict__ rowp, int tq, bool hm, bool hp, float w0, float w1, float w2, float bb, float (&u)[8]) {
  const f16x8 cur = *reinterpret_cast<const f16x8*>(rowp + tq);
  const float pm = hm ? (float)rowp[tq - 1] : 0.f, pn = hp ? (float)rowp[tq + 8] : 0.f;
  float x[10];
  x[0] = pm; x[9] = pn;
#pragma unroll
  for (int e = 0; e < 8; ++e) x[1 + e] = (float)cur[e];
#pragma unroll
  for (int e = 0; e < 8; ++e) u[e] = bb + w0 * x[e] + w1 * x[e + 1] + w2 * x[e + 2];
}
__device__ __forceinline__ void hy_u8s(const f16* __restrict__ rowp, int tq, bool hm, bool hp, int lane, float w0, float w1, float w2, float bb, float (&u)[8],
                                       const f16x8* pre = nullptr) {
  const f16x8 cur = pre ? *pre : *reinterpret_cast<const f16x8*>(rowp + tq);
  float pm = __shfl_up((float)cur[7], 1), pn = __shfl_down((float)cur[0], 1);
  if (lane == 0) pm = hm ? (float)rowp[tq - 1] : 0.f;
  if (lane == 63) pn = hp ? (float)rowp[tq + 8] : 0.f;
  if (!hm) pm = 0.f;
  if (!hp) pn = 0.f;
  float x[10];
  x[0] = pm; x[9] = pn;
#pragma unroll
  for (int e = 0; e < 8; ++e) x[1 + e] = (float)cur[e];
#pragma unroll
  for (int e = 0; e < 8; ++e) u[e] = bb + w0 * x[e] + w1 * x[e + 1] + w2 * x[e + 2];
}
__device__ __forceinline__ void phase_hyprep(const Params& p, int j, char* smem) {
  const int tid = opaque_tid();
  const f16* PT = reinterpret_cast<const f16*>(p.ws + OFF_PROJ);
  f16* ZT = reinterpret_cast<f16*>(p.ws + OFF_ZT);
  f16* MG = reinterpret_cast<f16*>(p.ws + OFF_MG);
  const float* cw = p.hy_conv_w + (size_t)j * 3 * 3072;
  const float* cb = p.hy_conv_b + (size_t)j * 3072;
  for (int t = VBID; t < 4096; t += VGRID) {
    const int c = t >> 2, tq = (t & 3) * 2048 + tid * 8;
    const int L = tq < 4096 ? 256 : 2048;
    const bool hm = (tq & (L - 1)) != 0, hp = ((tq + 8) & (L - 1)) != 0;
    float u0[8], u1[8], u2[8];
    hy_u8(PT + (size_t)c * 8192, tq, hm, hp, cw[c], cw[3072 + c], cw[6144 + c], cb[c], u0);
    hy_u8(PT + (size_t)(1024 + c) * 8192, tq, hm, hp, cw[1024 + c], cw[3072 + 1024 + c], cw[6144 + 1024 + c], cb[1024 + c], u1);
    hy_u8(PT + (size_t)(2048 + c) * 8192, tq, hm, hp, cw[2048 + c], cw[3072 + 2048 + c], cw[6144 + 2048 + c], cb[2048 + c], u2);
    const f16x8 g = *reinterpret_cast<const f16x8*>(PT + (size_t)(3072 + c) * 8192 + tq);
    f16x8 zo, mo;
#pragma unroll
    for (int e = 0; e < 8; ++e) {
      zo[e] = (f16)(u2[e] * u1[e]);
      mo[e] = (f16)(u0[e] * silu_f((float)g[e]));
    }
    *reinterpret_cast<f16x8*>(ZT + (size_t)c * 8192 + tq) = zo;
    *reinterpret_cast<f16x8*>(MG + (size_t)c * 8192 + tq) = mo;
  }
}

#define GSCALE 256.0f
__device__ __forceinline__ void phase_filter_norm(const Params& p) {
  const int tid = opaque_tid();
  float* GB = reinterpret_cast<float*>(p.ws + OFF_FRAW);
  const float* FS = reinterpret_cast<const float*>(p.ws + OFF_FSUM);
  for (int t = VBID; t < 2048; t += VGRID) {
    const int j = t >> 10, c = t & 1023;
    const float* FSUM = FS + (size_t)j * 9 * 2048;
    float sf2 = 0.f, sb2 = 0.f;
#pragma unroll
    for (int q = 1; q < 9; ++q) { sf2 += FSUM[q * 2048 + c]; sb2 += FSUM[q * 2048 + 1024 + c]; }
    const float sf1 = FSUM[c], sb1 = FSUM[1024 + c];
    const float bias = p.hy_f_bias[j * 1024 + c] * GSCALE;
    {
      float* G = GB + ((size_t)j * 1024 + c) * 4096;
      const float isf = GSCALE / sf2, isb = GSCALE / sb2;
      const float g0 = G[2048] * isf + G[0] * isb + bias;
      float4 v[4];
#pragma unroll
      for (int i = 0; i < 4; ++i) v[i] = reinterpret_cast<const float4*>(G)[tid + 256 * i];
      __syncthreads();
#pragma unroll
      for (int i = 0; i < 4; ++i) {
        const int q = tid + 256 * i;
        const float sc = q >= 512 ? isf : isb;
        float4 o = make_float4(v[i].x * sc, v[i].y * sc, v[i].z * sc, v[i].w * sc);
        if (q == 0) o.x = 0.f;
        if (q == 512) o.x = g0;
        reinterpret_cast<float4*>(G)[q] = o;
      }
    }
    {
      float* G = GB + (size_t)2 * 1024 * 4096 + ((size_t)j * 1024 + c) * 512;
      const float isf = GSCALE / sf1, isb = GSCALE / sb1;
      const float g0 = G[256] * isf + G[0] * isb + bias;
      float4 v = make_float4(0.f, 0.f, 0.f, 0.f);
      if (tid < 128) v = reinterpret_cast<const float4*>(G)[tid];
      __syncthreads();
      if (tid < 128) {
        const float sc = tid >= 64 ? isf : isb;
        float4 o = make_float4(v.x * sc, v.y * sc, v.z * sc, v.w * sc);
        if (tid == 0) o.x = 0.f;
        if (tid == 64) o.x = g0;
        reinterpret_cast<float4*>(G)[tid] = o;
      }
    }
  }
}

template <int L>
__device__ __forceinline__ void hyconv_pass(const Params& p, int j, int c, char* smem, int tid) {
  constexpr int NB = L / 32, QOFF = NB * 4, NQ = NB * 8, CS = NQ * 16 + 64;
  char* Gs = smem;
  char* Zs = smem + 8 * CS;
  const int w = tid >> 6, lane = tid & 63, r = lane & 31, hh = lane >> 5;
  const float* G = reinterpret_cast<const float*>(p.ws + OFF_FRAW) +
                   (L == 2048 ? ((size_t)j * 1024 + c) * 4096 : (size_t)2 * 1024 * 4096 + ((size_t)j * 1024 + c) * 512);
  f16* YT = reinterpret_cast<f16*>(p.ws + OFF_YT) + (size_t)c * 8192 + (L == 2048 ? 4096 : 0);
  f16* g16 = reinterpret_cast<f16*>(Zs);
  const int tokg = L == 2048 ? 4096 : 0;
  const f16* PT = reinterpret_cast<const f16*>(p.ws + OFF_PROJ);
  const f16* rx0 = PT + (size_t)c * 8192 + tokg;
  const f16* rx1 = PT + (size_t)(1024 + c) * 8192 + tokg;
  const f16* rv = PT + (size_t)(2048 + c) * 8192 + tokg;
  const f16* rg = PT + (size_t)(3072 + c) * 8192 + tokg;
  const float* cw = p.hy_conv_w + (size_t)j * 3 * 3072;
  const float* cb = p.hy_conv_b + (size_t)j * 3072;
  int b, i, dlo, dhi;
  if (L == 2048) { b = r >> 4; i = 16 * w + (r & 15); dlo = 16 * w - 63; dhi = 16 * w + 15; }
  else { const int n = w * 32 + r; b = n >> 3; i = n & 7; dlo = -7; dhi = 7; }
  f16x4 mgv[4];
  {
    const float w0 = cw[c], w1 = cw[3072 + c], w2 = cw[6144 + c], bb0 = cb[c];
#pragma unroll
    for (int g4 = 0; g4 < 4; ++g4) {
      const int to = b * L + 32 * i + 8 * g4 + 4 * hh;
      const f16x4 xc = *reinterpret_cast<const f16x4*>(rx0 + to);
      const f16x4 gv = *reinterpret_cast<const f16x4*>(rg + to);
      float x[6];
      x[0] = (to & (L - 1)) != 0 ? (float)rx0[to - 1] : 0.f;
      x[5] = ((to + 4) & (L - 1)) != 0 ? (float)rx0[to + 4] : 0.f;
#pragma unroll
      for (int q = 0; q < 4; ++q) x[1 + q] = (float)xc[q];
#pragma unroll
      for (int q = 0; q < 4; ++q)
        mgv[g4][q] = (f16)((bb0 + w0 * x[q] + w1 * x[q + 1] + w2 * x[q + 2]) * silu_f((float)gv[q]) * (1.0f / GSCALE) * 16.0f);
    }
  }
  f16x8 zreg[2];
#pragma unroll
  for (int q2 = 0; q2 < 2; ++q2) {
    const int u0 = (tid + 256 * q2) * 8;
    const bool hm = (u0 & (L - 1)) != 0, hp = ((u0 + 8) & (L - 1)) != 0;
    float u1[8], u2[8];
    hy_u8s(rx1, u0, hm, hp, lane, cw[1024 + c], cw[3072 + 1024 + c], cw[6144 + 1024 + c], cb[1024 + c], u1);
    hy_u8s(rv, u0, hm, hp, lane, cw[2048 + c], cw[3072 + 2048 + c], cw[6144 + 2048 + c], cb[2048 + c], u2);
#pragma unroll
    for (int e = 0; e < 8; ++e) zreg[q2][e] = (f16)(u2[e] * u1[e]);
  }
  for (int q = tid; q < L / 2; q += 256) {
    const float4 v = reinterpret_cast<const float4*>(G)[q];
    f16x4 o = {(f16)v.x, (f16)v.y, (f16)v.z, (f16)v.w};
    *reinterpret_cast<f16x4*>(g16 + q * 4) = o;
  }
  __syncthreads();
  for (int Qp = tid; Qp < NQ; Qp += 256) {
    const int i0 = 8 * (Qp - QOFF) + L - 8;
    f16x8 lo = {0, 0, 0, 0, 0, 0, 0, 0};
    if (i0 >= 0) lo = *reinterpret_cast<const f16x8*>(g16 + i0);
    const f16x8 hi = *reinterpret_cast<const f16x8*>(g16 + i0 + 8);
    f16 wv[16];
#pragma unroll
    for (int e = 0; e < 8; ++e) { wv[e] = lo[e]; wv[8 + e] = hi[e]; }
#pragma unroll
    for (int c8 = 0; c8 < 8; ++c8) {
      f16x8 o;
#pragma unroll
      for (int jj = 0; jj < 8; ++jj) o[jj] = wv[8 + c8 - jj];
      *reinterpret_cast<f16x8*>(Gs + c8 * CS + Qp * 16) = o;
    }
  }
  __syncthreads();
#pragma unroll
  for (int q2 = 0; q2 < 2; ++q2) {
    const int u0 = (tid + 256 * q2) * 8;
    *reinterpret_cast<f16x8*>(Zs + (u0 >> 5) * 80 + (u0 & 31) * 2) = zreg[q2];
  }
  __syncthreads();
  const int r1 = r >> 3, c8 = r & 7;
  f32x16 acc, acc1, acc2, acc3;
#pragma unroll
  for (int q = 0; q < 16; ++q) { acc[q] = 0.f; acc1[q] = 0.f; acc2[q] = 0.f; acc3[q] = 0.f; }
  const char* gbase = Gs + c8 * CS + (r1 - hh + QOFF) * 16;
  const char* zbase = Zs + (b * NB) * 80 + hh * 16;
  const f16x8 zero8 = {0, 0, 0, 0, 0, 0, 0, 0};
  int d = dlo;
  for (; d + 3 <= dhi; d += 4) {
    f16x8 af[4][2], bfv[4][2];
#pragma unroll
    for (int u = 0; u < 4; ++u) {
      const int jb = i - (d + u);
      const bool valid = (unsigned)jb < (unsigned)NB;
      const int jbc = valid ? jb : 0;
#pragma unroll
      for (int s2 = 0; s2 < 2; ++s2) {
        af[u][s2] = *reinterpret_cast<const f16x8*>(gbase + (4 * (d + u) - 2 * s2) * 16);
        f16x8 t = *reinterpret_cast<const f16x8*>(zbase + jbc * 80 + s2 * 32);
        bfv[u][s2] = valid ? t : zero8;
      }
    }
    __builtin_amdgcn_sched_barrier(0);
    acc = __builtin_amdgcn_mfma_f32_32x32x16_f16(af[0][0], bfv[0][0], acc, 0, 0, 0);
    acc1 = __builtin_amdgcn_mfma_f32_32x32x16_f16(af[0][1], bfv[0][1], acc1, 0, 0, 0);
    acc2 = __builtin_amdgcn_mfma_f32_32x32x16_f16(af[1][0], bfv[1][0], acc2, 0, 0, 0);
    acc3 = __builtin_amdgcn_mfma_f32_32x32x16_f16(af[1][1], bfv[1][1], acc3, 0, 0, 0);
    acc = __builtin_amdgcn_mfma_f32_32x32x16_f16(af[2][0], bfv[2][0], acc, 0, 0, 0);
    acc1 = __builtin_amdgcn_mfma_f32_32x32x16_f16(af[2][1], bfv[2][1], acc1, 0, 0, 0);
    acc2 = __builtin_amdgcn_mfma_f32_32x32x16_f16(af[3][0], bfv[3][0], acc2, 0, 0, 0);
    acc3 = __builtin_amdgcn_mfma_f32_32x32x16_f16(af[3][1], bfv[3][1], acc3, 0, 0, 0);
    __builtin_amdgcn_sched_barrier(0);
  }
  for (; d <= dhi; ++d) {
    const int jb = i - d;
    const bool valid = (unsigned)jb < (unsigned)NB;
    const int jbc = valid ? jb : 0;
    f16x8 a0 = *reinterpret_cast<const f16x8*>(gbase + (4 * d) * 16);
    f16x8 a1 = *reinterpret_cast<const f16x8*>(gbase + (4 * d - 2) * 16);
    f16x8 b0 = *reinterpret_cast<const f16x8*>(zbase + jbc * 80);
    f16x8 b1 = *reinterpret_cast<const f16x8*>(zbase + jbc * 80 + 32);
    if (!valid) { b0 = zero8; b1 = zero8; }
    acc = __builtin_amdgcn_mfma_f32_32x32x16_f16(a0, b0, acc, 0, 0, 0);
    acc1 = __builtin_amdgcn_mfma_f32_32x32x16_f16(a1, b1, acc1, 0, 0, 0);
  }
#pragma unroll
  for (int q = 0; q < 16; ++q) acc[q] = (acc[q] + acc1[q]) + (acc2[q] + acc3[q]);
#pragma unroll
  for (int g4 = 0; g4 < 4; ++g4) {
    const int to = b * L + 32 * i + 8 * g4 + 4 * hh;
    f16x4 o;
#pragma unroll
    for (int q = 0; q < 4; ++q) o[q] = (f16)(acc[g4 * 4 + q] * (1.0f / 16.0f) * (float)mgv[g4][q]);
    *reinterpret_cast<f16x4*>(YT + to) = o;
  }
  __syncthreads();
}

template <int L>
struct HyL {
  static constexpr int NB = L / 32, QOFF = NB * 4, NQ = NB * 8, CS = NQ * 16 + 64;
};
constexpr int HC_GS_S = 0;
constexpr int HC_GS_P = 8 * HyL<2048>::CS;
constexpr int HC_ZS_S = HC_GS_P + 8 * HyL<256>::CS;
constexpr int HC_ZS_P = HC_ZS_S + 128 * 80;
constexpr int HC_MG_S = HC_ZS_P + 128 * 80;
constexpr int HC_MG_P = HC_MG_S + 128 * 80;
constexpr int HC_RED = HC_MG_P + 128 * 80;
static_assert(HC_RED + 8 * 4096 <= 2 * LDS_HALF, "hyconv LDS");

template <int L>
__device__ __forceinline__ f16x8 hc_zchunk(const f16* rx1, const f16* rv, const float* cw, const float* cb, int c, int u0, int lane,
                                          const f16x8& px1, const f16x8& pv) {
  const bool hm = (u0 & (L - 1)) != 0, hp = ((u0 + 8) & (L - 1)) != 0;
  float u1[8], u2[8];
  hy_u8s(rx1, u0, hm, hp, lane, cw[1024 + c], cw[3072 + 1024 + c], cw[6144 + 1024 + c], cb[1024 + c], u1, &px1);
  hy_u8s(rv, u0, hm, hp, lane, cw[2048 + c], cw[3072 + 2048 + c], cw[6144 + 2048 + c], cb[2048 + c], u2, &pv);
  f16x8 z;
#pragma unroll
  for (int e = 0; e < 8; ++e) z[e] = (f16)(u2[e] * u1[e]);
  return z;
}
template <int L>
__device__ __forceinline__ f16x8 hc_gchunk(const f16* rx0, const f16* rg, const float* cw, const float* cb, int c, int u0, int lane,
                                          const f16x8& px0, const f16x8& gv) {
  const bool hm = (u0 & (L - 1)) != 0, hp = ((u0 + 8) & (L - 1)) != 0;
  float u[8];
  hy_u8s(rx0, u0, hm, hp, lane, cw[c], cw[3072 + c], cw[6144 + c], cb[c], u, &px0);
  f16x8 o;
#pragma unroll
  for (int e = 0; e < 8; ++e) o[e] = (f16)(u[e] * silu_f((float)gv[e]) * (16.0f / GSCALE));
  return o;
}
template <int L>
__device__ __forceinline__ void hc_build(char* Gs, const f16* g16, int Qp) {
  constexpr int QOFF = HyL<L>::QOFF, CS = HyL<L>::CS;
  const int i0 = 8 * (Qp - QOFF) + L - 8;
  f16x8 lo = {0, 0, 0, 0, 0, 0, 0, 0};
  if (i0 >= 0) lo = *reinterpret_cast<const f16x8*>(g16 + i0);
  const f16x8 hi = *reinterpret_cast<const f16x8*>(g16 + i0 + 8);
  f16 wv[16];
#pragma unroll
  for (int e = 0; e < 8; ++e) { wv[e] = lo[e]; wv[8 + e] = hi[e]; }
#pragma unroll
  for (int c8 = 0; c8 < 8; ++c8) {
    f16x8 o;
#pragma unroll
    for (int jj = 0; jj < 8; ++jj) o[jj] = wv[8 + c8 - jj];
    *reinterpret_cast<f16x8*>(Gs + c8 * CS + Qp * 16) = o;
  }
}
template <int L>
__device__ __forceinline__ void hc_gate(const f16* rx0, const f16* rg, const float* cw, const float* cb, int c, int b, int i, int hh, f16x4 (&mgv)[4]) {
  const float w0 = cw[c], w1 = cw[3072 + c], w2 = cw[6144 + c], bb0 = cb[c];
#pragma unroll
  for (int g4 = 0; g4 < 4; ++g4) {
    const int to = b * L + 32 * i + 8 * g4 + 4 * hh;
    const f16x4 xc = *reinterpret_cast<const f16x4*>(rx0 + to);
    const f16x4 gv = *reinterpret_cast<const f16x4*>(rg + to);
    float x[6];
    x[0] = (to & (L - 1)) != 0 ? (float)rx0[to - 1] : 0.f;
    x[5] = ((to + 4) & (L - 1)) != 0 ? (float)rx0[to + 4] : 0.f;
#pragma unroll
    for (int q = 0; q < 4; ++q) x[1 + q] = (float)xc[q];
#pragma unroll
    for (int q = 0; q < 4; ++q)
      mgv[g4][q] = (f16)((bb0 + w0 * x[q] + w1 * x[q + 1] + w2 * x[q + 2]) * silu_f((float)gv[q]) * (1.0f / GSCALE) * 16.0f);
  }
}
template <int L>
__device__ __forceinline__ f32x16 hc_acc(const char* Gs, const char* Zs, int b, int i, int dlo, int dhi, int r, int hh) {
  constexpr int NB = HyL<L>::NB, QOFF = HyL<L>::QOFF, CS = HyL<L>::CS;
  const int r1 = r >> 3, c8 = r & 7;
  f32x16 acc, acc1;
#pragma unroll
  for (int q = 0; q < 16; ++q) { acc[q] = 0.f; acc1[q] = 0.f; }
  const char* gbase = Gs + c8 * CS + (r1 - hh + QOFF) * 16;
  const char* zbase = Zs + (b * NB) * 80 + hh * 16;
  const f16x8 zero8 = {0, 0, 0, 0, 0, 0, 0, 0};
  int d = dlo;
  for (; d + 3 <= dhi; d += 4) {
    f16x8 af[4][2], bfv[4][2];
#pragma unroll
    for (int u = 0; u < 4; ++u) {
      const int jb = i - (d + u);
      const bool valid = (unsigned)jb < (unsigned)NB;
      const int jbc = valid ? jb : 0;
#pragma unroll
      for (int s2 = 0; s2 < 2; ++s2) {
        af[u][s2] = *reinterpret_cast<const f16x8*>(gbase + (4 * (d + u) - 2 * s2) * 16);
        f16x8 t = *reinterpret_cast<const f16x8*>(zbase + jbc * 80 + s2 * 32);
        bfv[u][s2] = valid ? t : zero8;
      }
    }
    __builtin_amdgcn_sched_barrier(0);
    acc = __builtin_amdgcn_mfma_f32_32x32x16_f16(af[0][0], bfv[0][0], acc, 0, 0, 0);
    acc1 = __builtin_amdgcn_mfma_f32_32x32x16_f16(af[0][1], bfv[0][1], acc1, 0, 0, 0);
    acc = __builtin_amdgcn_mfma_f32_32x32x16_f16(af[1][0], bfv[1][0], acc, 0, 0, 0);
    acc1 = __builtin_amdgcn_mfma_f32_32x32x16_f16(af[1][1], bfv[1][1], acc1, 0, 0, 0);
    acc = __builtin_amdgcn_mfma_f32_32x32x16_f16(af[2][0], bfv[2][0], acc, 0, 0, 0);
    acc1 = __builtin_amdgcn_mfma_f32_32x32x16_f16(af[2][1], bfv[2][1], acc1, 0, 0, 0);
    acc = __builtin_amdgcn_mfma_f32_32x32x16_f16(af[3][0], bfv[3][0], acc, 0, 0, 0);
    acc1 = __builtin_amdgcn_mfma_f32_32x32x16_f16(af[3][1], bfv[3][1], acc1, 0, 0, 0);
    __builtin_amdgcn_sched_barrier(0);
  }
  for (; d <= dhi; ++d) {
    const int jb = i - d;
    const bool valid = (unsigned)jb < (unsigned)NB;
    const int jbc = valid ? jb : 0;
    f16x8 a0 = *reinterpret_cast<const f16x8*>(gbase + (4 * d) * 16);
    f16x8 a1 = *reinterpret_cast<const f16x8*>(gbase + (4 * d - 2) * 16);
    f16x8 b0 = *reinterpret_cast<const f16x8*>(zbase + jbc * 80);
    f16x8 b1 = *reinterpret_cast<const f16x8*>(zbase + jbc * 80 + 32);
    if (!valid) { b0 = zero8; b1 = zero8; }
    acc = __builtin_amdgcn_mfma_f32_32x32x16_f16(a0, b0, acc, 0, 0, 0);
    acc1 = __builtin_amdgcn_mfma_f32_32x32x16_f16(a1, b1, acc1, 0, 0, 0);
  }
#pragma unroll
  for (int q = 0; q < 16; ++q) acc[q] = acc[q] + acc1[q];
  return acc;
}
template <int L>
__device__ __forceinline__ void hc_epi(const f32x16& acc, const char* MGs, f16* YT, int b, int i, int hh) {
  constexpr int NB = HyL<L>::NB;
#pragma unroll
  for (int g4 = 0; g4 < 4; ++g4) {
    const int to = b * L + 32 * i + 8 * g4 + 4 * hh;
    const f16x4 mg = *reinterpret_cast<const f16x4*>(MGs + (b * NB + i) * 80 + (8 * g4 + 4 * hh) * 2);
    f16x4 o;
#pragma unroll
    for (int q = 0; q < 4; ++q) o[q] = (f16)(acc[g4 * 4 + q] * (1.0f / 16.0f) * (float)mg[q]);
    *reinterpret_cast<f16x4*>(YT + to) = o;
  }
}

__device__ __forceinline__ void phase_hyconv(const Params& p, int j, char* smem) {
  const int tid = opaque_tid512(), w = tid >> 6, lane = tid & 63, r = lane & 31, hh = lane >> 5;
  const float* cw = p.hy_conv_w + (size_t)j * 3 * 3072;
  const float* cb = p.hy_conv_b + (size_t)j * 3072;
  const f16* PT = reinterpret_cast<const f16*>(p.ws + OFF_PROJ);
  float4 fS0, fS1, fP = make_float4(0.f, 0.f, 0.f, 0.f);
  {
    const int cf = __builtin_amdgcn_readfirstlane((int)blockIdx.x);
    const float4* GS4 = reinterpret_cast<const float4*>(reinterpret_cast<const float*>(p.ws + OFF_FRAW) + ((size_t)j * 1024 + cf) * 4096);
    const float4* GP4 = reinterpret_cast<const float4*>(reinterpret_cast<const float*>(p.ws + OFF_FRAW) + (size_t)2 * 1024 * 4096 + ((size_t)j * 1024 + cf) * 512);
    fS0 = GS4[tid]; fS1 = GS4[tid + 512];
    if (tid < 128) fP = GP4[tid];
  }
  f16x8 prw[8];
#define HC_LOAD_ROWS(CC_)                                                                        \
  {                                                                                              \
    const f16* b_ = PT + (size_t)(CC_) * 8192 + tid * 8;                                         \
    _Pragma("unroll") for (int q_ = 0; q_ < 4; ++q_) {                                           \
      prw[q_] = *reinterpret_cast<const f16x8*>(b_ + (size_t)q_ * 1024 * 8192 + 4096);          \
      prw[4 + q_] = *reinterpret_cast<const f16x8*>(b_ + (size_t)q_ * 1024 * 8192);             \
    }                                                                                            \
  }
  HC_LOAD_ROWS(__builtin_amdgcn_readfirstlane((int)blockIdx.x))
  for (int c0 = blockIdx.x; c0 < 1024; c0 += gridDim.x) {
    const int c = __builtin_amdgcn_readfirstlane(c0);
    const f16* rx0 = PT + (size_t)c * 8192;
    const f16* rx1 = PT + (size_t)(1024 + c) * 8192;
    const f16* rv = PT + (size_t)(2048 + c) * 8192;
    const f16* rg = PT + (size_t)(3072 + c) * 8192;
    f16* YT = reinterpret_cast<f16*>(p.ws + OFF_YT) + (size_t)c * 8192;
    const int ct = w & 3, half = w >> 2;
    const int bS = r >> 4, iS = 16 * ct + (r & 15);
    const int dloS = half ? 16 * ct - 63 + 40 : 16 * ct - 63, dhiS = half ? 16 * ct + 15 : 16 * ct - 63 + 39;
    const int nP = ct * 32 + r, bP = nP >> 3, iP = nP & 7;
    const int dloP = half ? 1 : -7, dhiP = half ? 7 : 0;
    const f16x8 gS = hc_gchunk<2048>(rx0 + 4096, rg + 4096, cw, cb, c, tid * 8, lane, prw[0], prw[3]);
    const f16x8 gP = hc_gchunk<256>(rx0, rg, cw, cb, c, tid * 8, lane, prw[4], prw[7]);
    const f16x8 zS = hc_zchunk<2048>(rx1 + 4096, rv + 4096, cw, cb, c, tid * 8, lane, prw[1], prw[2]);
    const f16x8 zP = hc_zchunk<256>(rx1, rv, cw, cb, c, tid * 8, lane, prw[5], prw[6]);
    f16* g16S = reinterpret_cast<f16*>(smem + HC_ZS_S);
    f16* g16P = reinterpret_cast<f16*>(smem + HC_ZS_P);
    *reinterpret_cast<f16x4*>(g16S + tid * 4) = f16x4{(f16)fS0.x, (f16)fS0.y, (f16)fS0.z, (f16)fS0.w};
    *reinterpret_cast<f16x4*>(g16S + (tid + 512) * 4) = f16x4{(f16)fS1.x, (f16)fS1.y, (f16)fS1.z, (f16)fS1.w};
    if (tid < 128) *reinterpret_cast<f16x4*>(g16P + tid * 4) = f16x4{(f16)fP.x, (f16)fP.y, (f16)fP.z, (f16)fP.w};
    __syncthreads();
    hc_build<2048>(smem + HC_GS_S, g16S, tid);
    if (tid >= 448) hc_build<256>(smem + HC_GS_P, g16P, tid - 448);
    __syncthreads();
    {
      const int u0 = tid * 8;
      *reinterpret_cast<f16x8*>(smem + HC_ZS_S + (u0 >> 5) * 80 + (u0 & 31) * 2) = zS;
      *reinterpret_cast<f16x8*>(smem + HC_ZS_P + (u0 >> 5) * 80 + (u0 & 31) * 2) = zP;
      *reinterpret_cast<f16x8*>(smem + HC_MG_S + (u0 >> 5) * 80 + (u0 & 31) * 2) = gS;
      *reinterpret_cast<f16x8*>(smem + HC_MG_P + (u0 >> 5) * 80 + (u0 & 31) * 2) = gP;
    }
    __syncthreads();
    if (c0 + (int)gridDim.x < 1024) {
      const int cf = __builtin_amdgcn_readfirstlane(c0 + (int)gridDim.x);
      const float4* GS4 = reinterpret_cast<const float4*>(reinterpret_cast<const float*>(p.ws + OFF_FRAW) + ((size_t)j * 1024 + cf) * 4096);
      const float4* GP4 = reinterpret_cast<const float4*>(reinterpret_cast<const float*>(p.ws + OFF_FRAW) + (size_t)2 * 1024 * 4096 + ((size_t)j * 1024 + cf) * 512);
      fS0 = GS4[tid]; fS1 = GS4[tid + 512];
      if (tid < 128) fP = GP4[tid];
      HC_LOAD_ROWS(cf)
    }
    f32x16 accS = hc_acc<2048>(smem + HC_GS_S, smem + HC_ZS_S, bS, iS, dloS, dhiS, r, hh);
    f32x16 accP = hc_acc<256>(smem + HC_GS_P, smem + HC_ZS_P, bP, iP, dloP, dhiP, r, hh);
    float* redS = reinterpret_cast<float*>(smem + HC_RED + (ct * 2 + 0) * 4096) + lane * 16;
    float* redP = reinterpret_cast<float*>(smem + HC_RED + (ct * 2 + 1) * 4096) + lane * 16;
    if (half) {
#pragma unroll
      for (int q = 0; q < 4; ++q) {
        *reinterpret_cast<f32x4*>(redS + 4 * q) = f32x4{accS[4 * q], accS[4 * q + 1], accS[4 * q + 2], accS[4 * q + 3]};
        *reinterpret_cast<f32x4*>(redP + 4 * q) = f32x4{accP[4 * q], accP[4 * q + 1], accP[4 * q + 2], accP[4 * q + 3]};
      }
    }
    __syncthreads();
    if (!half) {
#pragma unroll
      for (int q = 0; q < 4; ++q) {
        const f32x4 a = *reinterpret_cast<const f32x4*>(redS + 4 * q), bq = *reinterpret_cast<const f32x4*>(redP + 4 * q);
#pragma unroll
        for (int e = 0; e < 4; ++e) { accS[4 * q + e] += a[e]; accP[4 * q + e] += bq[e]; }
      }
      hc_epi<2048>(accS, smem + HC_MG_S, YT + 4096, bS, iS, hh);
      hc_epi<256>(accP, smem + HC_MG_P, YT, bP, iP, hh);
    }
    __syncthreads();
  }
}

__device__ __forceinline__ void phase_hygate(const Params& p, char* smem) {
  f16(*yt)[72] = reinterpret_cast<f16(*)[72]>(smem);
  const int tid = opaque_tid();
  const f16* YT = reinterpret_cast<const f16*>(p.ws + OFF_YT);
  const f16* MG = reinterpret_cast<const f16*>(p.ws + OFF_MG);
  f16* A2 = reinterpret_cast<f16*>(p.ws + OFF_A2);
  for (int t = VBID; t < 2048; t += VGRID) {
    const int tok0 = (t & 127) * 64, c0 = (t >> 7) * 64;
    {
      const int cc = tid >> 2, seg = tid & 3;
      const f16* s = YT + (size_t)(c0 + cc) * 8192 + tok0 + seg * 16;
      *reinterpret_cast<f16x8*>(&yt[cc][seg * 16]) = *reinterpret_cast<const f16x8*>(s);
      *reinterpret_cast<f16x8*>(&yt[cc][seg * 16 + 8]) = *reinterpret_cast<const f16x8*>(s + 8);
    }
    __syncthreads();
    const int cgp = tid & 7, tr = tid >> 3;
#pragma unroll
    for (int rr = 0; rr < 2; ++rr) {
      const int trow = tr + rr * 32, tok = tok0 + trow;
      f16x8 mg = *reinterpret_cast<const f16x8*>(MG + (size_t)tok * 1024 + c0 + cgp * 8);
      f16x8 o;
#pragma unroll
      for (int e = 0; e < 8; ++e) o[e] = (f16)((float)yt[cgp * 8 + e][trow] * (float)mg[e]);
      *reinterpret_cast<f16x8*>(A2 + (size_t)tok * 1024 + c0 + cgp * 8) = o;
    }
    __syncthreads();
  }
}

__device__ __forceinline__ void phase_mlaprep(const Params& p, int j, int mode) {
  const int tid = opaque_tid(), w = tid >> 6, lane = tid & 63;
  const f16* PROJ = reinterpret_cast<const f16*>(p.ws + OFF_PROJ);
  f16* QN = reinterpret_cast<f16*>(p.ws + M_QN);
  f16* CKV = reinterpret_cast<f16*>(p.ws + M_CKV);
  f16* KPEP = reinterpret_cast<f16*>(p.ws + M_KPEP);
  f16* KPES = reinterpret_cast<f16*>(p.ws + M_KPES);
  float* st_ckv = p.out + 2 * 4194304;
  float* st_kpe = st_ckv + 2097152;
  const f16x8 zero8 = {0, 0, 0, 0, 0, 0, 0, 0};
  const int tlo = mode == 0 ? 2048 : 0, thi = mode == 0 ? NKV / 4 : 2048;
  for (int t = tlo + VBID; t < thi; t += VGRID) {
    const int row = t * 4 + w;
    if (row < 8192) {
      const f16* pr = PROJ + (size_t)row * MLA_IN;
      const f16x8 c0 = *reinterpret_cast<const f16x8*>(pr + lane * 8);
      f16x8 c1 = zero8;
      if (lane < 20) c1 = *reinterpret_cast<const f16x8*>(pr + 512 + lane * 8);
      float f0[8], f1[8], s0 = 0.f, s1 = 0.f;
#pragma unroll
      for (int e = 0; e < 8; ++e) { f0[e] = (float)c0[e]; f1[e] = (float)c1[e]; s0 += f0[e] * f0[e]; s1 += f1[e] * f1[e]; }
      const float ssq = wave_sum(lane < 48 ? s0 : 0.f);
      const float sskv = wave_sum((lane >= 48 ? s0 : 0.f) + (lane < 16 ? s1 : 0.f));
      const float rq = rsqrtf(ssq * (1.f / 384.f) + 1e-6f), rkv = rsqrtf(sskv * (1.f / 256.f) + 1e-6f);
      const bool prompt = row < 4096;
      const int b = prompt ? row >> 8 : (row - 4096) >> 11, tq = prompt ? row & 255 : (row - 4096) & 2047;
      if (lane < 48) {
        const float4 g0 = *reinterpret_cast<const float4*>(p.mla_q_norm + j * 384 + lane * 8);
        const float4 g1 = *reinterpret_cast<const float4*>(p.mla_q_norm + j * 384 + lane * 8 + 4);
        f16x8 o;
        o[0] = (f16)(f0[0] * rq * g0.x); o[1] = (f16)(f0[1] * rq * g0.y); o[2] = (f16)(f0[2] * rq * g0.z); o[3] = (f16)(f0[3] * rq * g0.w);
        o[4] = (f16)(f0[4] * rq * g1.x); o[5] = (f16)(f0[5] * rq * g1.y); o[6] = (f16)(f0[6] * rq * g1.z); o[7] = (f16)(f0[7] * rq * g1.w);
        (void)o; (void)QN;
      }
      if (lane >= 48 || lane < 16) {
        const int kc = lane >= 48 ? (lane - 48) * 8 : (16 + lane) * 8;
        const float4 g0 = *reinterpret_cast<const float4*>(p.mla_kv_norm + j * 256 + kc);
        const float4 g1 = *reinterpret_cast<const float4*>(p.mla_kv_norm + j * 256 + kc + 4);
        float v[8];
#pragma unroll
        for (int e = 0; e < 8; ++e) v[e] = (lane >= 48 ? f0[e] : f1[e]) * rkv;
        v[0] *= g0.x; v[1] *= g0.y; v[2] *= g0.z; v[3] *= g0.w; v[4] *= g1.x; v[5] *= g1.y; v[6] *= g1.z; v[7] *= g1.w;
        f16x8 o;
#pragma unroll
        for (int e = 0; e < 8; ++e) o[e] = (f16)v[e];
        (void)o;
        if (prompt) {
          float* d = st_ckv + (((size_t)b * 2 + j) * 256 + tq) * 256 + kc;
#pragma unroll
          for (int e = 0; e < 8; ++e) __builtin_nontemporal_store(v[e], d + e);
        }
      }
      float oth[8];
#pragma unroll
      for (int e = 0; e < 8; ++e) oth[e] = __shfl_xor(f1[e], 1);
      if (lane >= 16 && lane < 20) {
        const int q = lane - 16;
        if (prompt) {
          f16x8 o;
#pragma unroll
          for (int e = 0; e < 8; ++e) o[e] = (f16)f1[e];
          *reinterpret_cast<f16x8*>(KPEP + (size_t)row * 32 + q * 8) = o;
          float* d = st_kpe + (((size_t)b * 2 + j) * 256 + tq) * 32 + q * 8;
          *reinterpret_cast<float4*>(d) = make_float4(f1[0], f1[1], f1[2], f1[3]);
          *reinterpret_cast<float4*>(d + 4) = make_float4(f1[4], f1[5], f1[6], f1[7]);
        } else {
          const float pos = (q >> 1) == 0 ? (float)(tq >> 6) : (float)(tq & 63);
          f16x8 o;
#pragma unroll
          for (int e = 0; e < 8; ++e) {
            const float inv = exp2f(-(float)(2 * e) * (13.287712379549449f / 16.f));
            const float ang = pos * inv;
            const float cs = cosf(ang), sn = sinf(ang);
            o[e] = (f16)((q & 1) == 0 ? f1[e] * cs - oth[e] * sn : f1[e] * cs + oth[e] * sn);
          }
          *reinterpret_cast<f16x8*>(KPES + ((size_t)b * 2560 + tq) * 32 + q * 8) = o;
        }
      }
    } else {
      const int cr = row - 8192, b = cr >> 9, key = cr & 511;
      const float* src = p.cache_ckv + (((size_t)b * 2 + j) * 512 + key) * 256;
      const float4 v = *reinterpret_cast<const float4*>(src + lane * 4);
      f16x4 o = {(f16)v.x, (f16)v.y, (f16)v.z, (f16)v.w};
      *reinterpret_cast<f16x4*>(CKV + (size_t)row * 256 + lane * 4) = o;
      if (lane < 32)
        KPES[((size_t)b * 2560 + 2048 + key) * 32 + lane] = (f16)p.cache_kpe[(((size_t)b * 2 + j) * 512 + key) * 32 + lane];
    }
  }
}

__device__ __forceinline__ void phase_attn(const Params& p, char* smem) {
  const int tid = opaque_tid512(), w = tid >> 6, lane = tid & 63, r = lane & 31, hh = lane >> 5;
  constexpr int ATT_BUF = 64 * 208 + 64 * 144;
  const f16* Q = reinterpret_cast<const f16*>(p.ws + M_Q);
  const f16* PROJ = reinterpret_cast<const f16*>(p.ws + OFF_PROJ);
  f16* A2 = reinterpret_cast<f16*>(p.ws + OFF_A2);
  const int G = gridDim.x;
  for (int t0 = blockIdx.x; t0 < 512; t0 += G) {
    int t = t0;
    if (G == 256) {
      const int v = t0 & 255, x = v & 7, li = v >> 3;
      t = (t0 & 256) + x * 32 + li;
    }
    const bool sample = t < 256;
    int bh, qc, Lk;
    if (sample) { bh = t >> 3; qc = t & 7; Lk = 2560; } else { bh = t - 256; qc = 0; Lk = 256; }
    const int b = bh >> 4, h = bh & 15;
    const int tq = qc * 256 + w * 32 + r;
    const int tok = sample ? 4096 + b * 2048 + tq : b * 256 + tq;
    const f16* KN = reinterpret_cast<const f16*>(p.ws + (sample ? M_KNS : M_KNP)) + (size_t)bh * Lk * 64;
    const f16* VT = reinterpret_cast<const f16*>(p.ws + (sample ? M_VTS : M_VTP)) + (size_t)bh * 64 * Lk;
    const f16* KPE = reinterpret_cast<const f16*>(p.ws + (sample ? M_KPES : M_KPEP)) + (size_t)b * Lk * 32;
    f16x8 qf[6];
    const f16* qp = Q + (size_t)tok * 1536 + h * 96;
#pragma unroll
    for (int ks = 0; ks < 4; ++ks) qf[ks] = *reinterpret_cast<const f16x8*>(qp + ks * 16 + hh * 8);
    if (!sample) {
      qf[4] = *reinterpret_cast<const f16x8*>(qp + 64 + hh * 8);
      qf[5] = *reinterpret_cast<const f16x8*>(qp + 80 + hh * 8);
    } else {
#pragma unroll
      for (int g = 0; g < 2; ++g) {
        const f16x8 x1 = *reinterpret_cast<const f16x8*>(qp + 64 + g * 16);
        const f16x8 x2 = *reinterpret_cast<const f16x8*>(qp + 64 + g * 16 + 8);
        const float pos = g == 0 ? (float)(tq >> 6) : (float)(tq & 63);
#pragma unroll
        for (int i = 0; i < 8; ++i) {
          const float inv = exp2f(-(float)(2 * i) * (13.287712379549449f / 16.f));
          const float ang = pos * inv;
          const float cs = cosf(ang), sn = sinf(ang);
          const float a1 = (float)x1[i], a2 = (float)x2[i];
          qf[4 + g][i] = (f16)(hh == 0 ? a1 * cs - a2 * sn : a2 * cs + a1 * sn);
        }
      }
    }
    f32x16 O0, O1;
#pragma unroll
    for (int q = 0; q < 16; ++q) { O0[q] = 0.f; O1[q] = 0.f; }
    float m = -1e30f;
    f32x2 lacc = {0.f, 0.f};
    const int nkt = Lk >> 6;
    f16x8 pk0, pkpe, pv0;
    const f16* kn_t = KN + (size_t)(tid >> 3) * 64 + (tid & 7) * 8;
    const f16* kpe_t = KPE + (size_t)((tid & 255) >> 2) * 32 + (tid & 3) * 8;
    const f16* vt_t = VT + (size_t)(tid >> 3) * Lk + (tid & 7) * 8;
    const int kw0 = (tid >> 3) * 208 + (tid & 7) * 16, kwp = ((tid & 255) >> 2) * 208 + 128 + (tid & 3) * 16;
    const int vw0 = (tid >> 3) * 144 + ((tid & 7) >> 1) * 32 + ((tid & 7) & 1) * 8;
    const bool lowhalf = tid < 256;
#define ATT_LOAD(KT_)                                                                      \
  {                                                                                        \
    const int key0_ = (KT_) * 64;                                                          \
    pk0 = *reinterpret_cast<const f16x8*>(kn_t + (size_t)key0_ * 64);                      \
    if (lowhalf) pkpe = *reinterpret_cast<const f16x8*>(kpe_t + (size_t)key0_ * 32);       \
    pv0 = *reinterpret_cast<const f16x8*>(vt_t + key0_);                                   \
  }
#define ATT_STORE(BUF_)                                                                    \
  {                                                                                        \
    char* kb_ = smem + (BUF_) * ATT_BUF;                                                   \
    char* vb_ = kb_ + 64 * 208;                                                            \
    *reinterpret_cast<f16x8*>(kb_ + kw0) = pk0;                                            \
    if (lowhalf) *reinterpret_cast<f16x8*>(kb_ + kwp) = pkpe;                              \
    *reinterpret_cast<f16x4*>(vb_ + vw0) = f16x4{pv0[0], pv0[1], pv0[2], pv0[3]};          \
    *reinterpret_cast<f16x4*>(vb_ + vw0 + 16) = f16x4{pv0[4], pv0[5], pv0[6], pv0[7]};     \
  }
    const bool rot = tid >= 256;
    f32x16 s0, s1;
#define ATT_QK(BUFI_)                                                                               \
  {                                                                                                 \
    const char* KS_ = smem + (BUFI_) * ATT_BUF;                                                     \
    f16x8 ka0[6], ka1[6];                                                                           \
    _Pragma("unroll") for (int ks = 0; ks < 6; ++ks) {                                              \
      ka0[ks] = *reinterpret_cast<const f16x8*>(KS_ + r * 208 + ks * 32 + hh * 16);                 \
      ka1[ks] = *reinterpret_cast<const f16x8*>(KS_ + (32 + r) * 208 + ks * 32 + hh * 16);          \
    }                                                                                               \
    _Pragma("unroll") for (int q = 0; q < 16; ++q) { s0[q] = 0.f; s1[q] = 0.f; }                    \
    __builtin_amdgcn_sched_barrier(0);                                                              \
    _Pragma("unroll") for (int ks = 0; ks < 6; ++ks) {                                              \
      s0 = __builtin_amdgcn_mfma_f32_32x32x16_f16(ka0[ks], qf[ks], s0, 0, 0, 0);                    \
      s1 = __builtin_amdgcn_mfma_f32_32x32x16_f16(ka1[ks], qf[ks], s1, 0, 0, 0);                    \
    }                                                                                               \
  }
    {
      f16x8 qk0, qkpe, qv0;
      pk0 = *reinterpret_cast<const f16x8*>(kn_t);
      if (lowhalf) pkpe = *reinterpret_cast<const f16x8*>(kpe_t);
      pv0 = *reinterpret_cast<const f16x8*>(vt_t);
      qk0 = *reinterpret_cast<const f16x8*>(kn_t + (size_t)64 * 64);
      if (lowhalf) qkpe = *reinterpret_cast<const f16x8*>(kpe_t + (size_t)64 * 32);
      qv0 = *reinterpret_cast<const f16x8*>(vt_t + 64);
      ATT_STORE(0)
      pk0 = qk0; pv0 = qv0;
      if (lowhalf) pkpe = qkpe;
      ATT_STORE(1)
    }
    if (nkt > 2) ATT_LOAD(2)
    __syncthreads();
    ATT_QK(0)
    int bcur = 0;
    for (int kt = 0; kt < nkt; ++kt) {
      const int bnext = bcur == 2 ? 0 : bcur + 1, bnext2 = bnext == 2 ? 0 : bnext + 1;
      if (!rot) __syncthreads();
      const char* VS = smem + bcur * ATT_BUF + 64 * 208;
      float mx;
      {
        float t0, t1, t2, t3;
        asm volatile("s_nop 15\n\ts_nop 7");
        asm("v_max3_f32 %0, %1, %2, %3" : "=v"(t0) : "v"(s0[0]), "v"(s0[1]), "v"(s0[2]));
        asm("v_max3_f32 %0, %1, %2, %3" : "=v"(t1) : "v"(s0[3]), "v"(s0[4]), "v"(s0[5]));
        asm("v_max3_f32 %0, %1, %2, %3" : "=v"(t2) : "v"(s0[6]), "v"(s0[7]), "v"(s0[8]));
        asm("v_max3_f32 %0, %1, %2, %3" : "=v"(t3) : "v"(s0[9]), "v"(s0[10]), "v"(s0[11]));
        asm("v_max3_f32 %0, %1, %2, %3" : "=v"(t0) : "v"(t0), "v"(s0[12]), "v"(s0[13]));
        asm("v_max3_f32 %0, %1, %2, %3" : "=v"(t1) : "v"(t1), "v"(s0[14]), "v"(s0[15]));
        asm("v_max3_f32 %0, %1, %2, %3" : "=v"(t2) : "v"(t2), "v"(s1[0]), "v"(s1[1]));
        asm("v_max3_f32 %0, %1, %2, %3" : "=v"(t3) : "v"(t3), "v"(s1[2]), "v"(s1[3]));
        asm("v_max3_f32 %0, %1, %2, %3" : "=v"(t0) : "v"(t0), "v"(s1[4]), "v"(s1[5]));
        asm("v_max3_f32 %0, %1, %2, %3" : "=v"(t1) : "v"(t1), "v"(s1[6]), "v"(s1[7]));
        asm("v_max3_f32 %0, %1, %2, %3" : "=v"(t2) : "v"(t2), "v"(s1[8]), "v"(s1[9]));
        asm("v_max3_f32 %0, %1, %2, %3" : "=v"(t3) : "v"(t3), "v"(s1[10]), "v"(s1[11]));
        asm("v_max3_f32 %0, %1, %2, %3" : "=v"(t0) : "v"(t0), "v"(s1[12]), "v"(s1[13]));
        asm("v_max3_f32 %0, %1, %2, %3" : "=v"(t1) : "v"(t1), "v"(s1[14]), "v"(s1[15]));
        asm("v_max3_f32 %0, %1, %2, %3" : "=v"(t0) : "v"(t0), "v"(t1), "v"(t2));
        asm("v_max_f32 %0, %1, %2" : "=v"(mx) : "v"(t0), "v"(t3));
      }
      mx = fmaxf(mx, __shfl_xor(mx, 32));
      if (__builtin_amdgcn_ballot_w64(mx > m + 8.f) != 0ull) {
        const float mn = fmaxf(m, mx);
        const float alpha = __builtin_amdgcn_exp2f(m - mn);
        m = mn;
        lacc *= alpha;
        O0 *= alpha;
        O1 *= alpha;
      }
      const f32x2 mm = {m, m};
      f16x8 pf[4];
#pragma unroll
      for (int s2 = 0; s2 < 2; ++s2)
#pragma unroll
        for (int jj = 0; jj < 8; jj += 2) {
          const f32x2 d0 = f32x2{s0[8 * s2 + jj], s0[8 * s2 + jj + 1]} - mm;
          const f32x2 d1 = f32x2{s1[8 * s2 + jj], s1[8 * s2 + jj + 1]} - mm;
          const f32x2 e0 = {__builtin_amdgcn_exp2f(d0[0]), __builtin_amdgcn_exp2f(d0[1])};
          const f32x2 e1 = {__builtin_amdgcn_exp2f(d1[0]), __builtin_amdgcn_exp2f(d1[1])};
          lacc += e0;
          lacc += e1;
          pf[s2][jj] = (f16)e0[0]; pf[s2][jj + 1] = (f16)e0[1];
          pf[2 + s2][jj] = (f16)e1[0]; pf[2 + s2][jj + 1] = (f16)e1[1];
        }
      f16x8 vfa[4], vfb[4];
#pragma unroll
      for (int us = 0; us < 4; ++us) {
        const char* vp0 = VS + r * 144 + ((us >> 1) * 32 + 16 * (us & 1) + 8 * hh) * 2;
        vfa[us] = *reinterpret_cast<const f16x8*>(vp0);
        vfb[us] = *reinterpret_cast<const f16x8*>(vp0 + 32 * 144);
      }
#pragma unroll
      for (int us = 0; us < 4; ++us) {
        O0 = __builtin_amdgcn_mfma_f32_32x32x16_f16(vfa[us], pf[us], O0, 0, 0, 0);
        O1 = __builtin_amdgcn_mfma_f32_32x32x16_f16(vfb[us], pf[us], O1, 0, 0, 0);
      }
      if (rot) __syncthreads();
      if (kt + 1 < nkt) ATT_QK(bnext)
      if (kt + 2 < nkt) ATT_STORE(bnext2)
      if (kt + 3 < nkt) ATT_LOAD(kt + 3)
      bcur = bnext;
    }
    __syncthreads();
#undef ATT_QK
#undef ATT_LOAD
#undef ATT_STORE
    float l = lacc[0] + lacc[1];
    l += __shfl_xor(l, 32);
    const float il = 1.f / l;
#pragma unroll
    for (int dt = 0; dt < 2; ++dt)
#pragma unroll
      for (int g4 = 0; g4 < 4; ++g4) {
        const int dv0 = 32 * dt + 8 * g4 + 4 * hh;
        const f16x4 gt = *reinterpret_cast<const f16x4*>(PROJ + (size_t)tok * MLA_IN + 672 + h * 64 + dv0);
        f16x4 o;
#pragma unroll
        for (int q = 0; q < 4; ++q) {
          const float ov = dt == 0 ? O0[g4 * 4 + q] : O1[g4 * 4 + q];
          o[q] = (f16)(ov * il * silu_f((float)gt[q]));
        }
        *reinterpret_cast<f16x4*>(A2 + (size_t)tok * 1024 + h * 64 + dv0) = o;
      }
  }
}

__device__ __forceinline__ void phase_final(const Params& p) {
  const int tid = opaque_tid(), w = tid >> 6, lane = tid & 63;
  const float4* X = reinterpret_cast<const float4*>(p.ws + OFF_X);
  const float4* nw = reinterpret_cast<const float4*>(p.final_norm);
  float4* O = reinterpret_cast<float4*>(p.out);
  for (int t = VBID; t < 2048; t += VGRID) {
    const int row = t * 4 + w;
    float4 v[4];
    float ss = 0.f;
#pragma unroll
    for (int i = 0; i < 4; ++i) {
      { const f32x4 q_ = __builtin_nontemporal_load(reinterpret_cast<const f32x4*>(X + (size_t)row * 256 + lane + 64 * i)); v[i] = make_float4(q_[0], q_[1], q_[2], q_[3]); }
      ss += v[i].x * v[i].x + v[i].y * v[i].y + v[i].z * v[i].z + v[i].w * v[i].w;
    }
    ss = wave_sum(ss);
    const float rstd = rsqrtf(ss * (1.f / 1024.f) + 1e-6f);
#pragma unroll
    for (int i = 0; i < 4; ++i) {
      const int q = lane + 64 * i;
      float4 g = nw[q];
      float* op_ = reinterpret_cast<float*>(O + (size_t)row * 256 + q);
      __builtin_nontemporal_store(v[i].x * rstd * g.x, op_); __builtin_nontemporal_store(v[i].y * rstd * g.y, op_ + 1);
      __builtin_nontemporal_store(v[i].z * rstd * g.z, op_ + 2); __builtin_nontemporal_store(v[i].w * rstd * g.w, op_ + 3);
    }
  }
}

#define XB_TMO      128
#define XB_XCNT(j)  (256  + 64 * (j))
#define XB_XSUB(j)  (1280 + 64 * (j))
#define XB_XGEN(j)  (2304 + 64 * (j))
#define XB_TOP      3328
#define XB_TOPGEN   3392
#define XCD_BAR_WORDS 3456
#define XB_SPIN_CAP (1u << 22)
#define LAS __attribute__((address_space(3)))
__device__ __forceinline__ unsigned xb_ld(unsigned* p) { return __hip_atomic_load(p, __ATOMIC_RELAXED, __HIP_MEMORY_SCOPE_AGENT); }
__device__ __forceinline__ unsigned xb_add(unsigned* p, unsigned v) { return __hip_atomic_fetch_add(p, v, __ATOMIC_RELAXED, __HIP_MEMORY_SCOPE_AGENT); }
__device__ __forceinline__ unsigned xb_xcc_id() { return (unsigned)__builtin_amdgcn_s_getreg((3 << 11) | 20) & 0xFu; }
#define XB_SPIN(cond, bar) do { unsigned _sp = 0; while (cond) { __builtin_amdgcn_s_sleep(1); \
    if ((++_sp & 255u) == 0u) { if (xb_ld(&(bar)[XB_TMO])) break; if (_sp > XB_SPIN_CAP) { atomicAdd(&(bar)[XB_TMO], 1u); break; } } } } while (0)
struct XcdBarrier { unsigned* bar; unsigned x; volatile LAS unsigned* st; };
__device__ __forceinline__ XcdBarrier xcd_barrier_post(unsigned* bar, volatile LAS unsigned* st) {
  XcdBarrier b; b.bar = bar; b.x = xb_xcc_id(); b.st = st;
  if (threadIdx.x == 0) (void)xb_add(&bar[XB_XCNT(b.x)], 1u);
  return b;
}
__device__ __forceinline__ void xcd_barrier_complete(unsigned* bar, unsigned x, unsigned& nloc, unsigned& nx) {
  const unsigned G = gridDim.x * gridDim.y * gridDim.z;
  unsigned sum, cnt, mine, sp = 0u;
  for (;;) {
    sum = 0u; cnt = 0u; mine = 0u;
#pragma unroll
    for (unsigned j = 0; j < 16; ++j) { const unsigned c = xb_ld(&bar[XB_XCNT(j)]); sum += c; cnt += (c > 0u) ? 1u : 0u; mine = (j == x) ? c : mine; }
    if (sum == G) break;
    __builtin_amdgcn_s_sleep(1);
    if ((++sp & 255u) == 0u) { if (xb_ld(&bar[XB_TMO])) break; if (sp > XB_SPIN_CAP) { atomicAdd(&bar[XB_TMO], 1u); break; } }
  }
  nloc = mine > 0u ? mine : 1u; nx = cnt > 0u ? cnt : 1u;
}
__device__ __forceinline__ void xcd_barrier(const XcdBarrier& b) {
  asm volatile("s_waitcnt vmcnt(0)" ::: "memory");
  __syncthreads();
  if (threadIdx.x == 0) {
    unsigned* bar = b.bar;
    __builtin_amdgcn_s_waitcnt(0);
    unsigned nloc = b.st[0], nx = b.st[1];
    if (nloc == 0u) { xcd_barrier_complete(bar, b.x, nloc, nx); b.st[0] = nloc; b.st[1] = nx; }
    const unsigned old = xb_add(&bar[XB_XSUB(b.x)], 1u);
    const unsigned gen = old / nloc;
    if (old + 1u == (gen + 1u) * nloc) {
      __builtin_amdgcn_fence(__ATOMIC_RELEASE, "agent");
      asm volatile("s_waitcnt vmcnt(0)" ::: "memory");
      const unsigned og = xb_add(&bar[XB_TOP], 1u);
      const unsigned tg = og / nx;
      if (og + 1u == (tg + 1u) * nx) xb_add(&bar[XB_TOPGEN], 1u);
      else XB_SPIN(xb_ld(&bar[XB_TOPGEN]) == tg, bar);
      __builtin_amdgcn_fence(__ATOMIC_ACQUIRE, "agent");
      xb_add(&bar[XB_XGEN(b.x)], 1u);
      asm volatile("s_waitcnt vmcnt(0)" ::: "memory");
    } else {
      XB_SPIN(xb_ld(&bar[XB_XGEN(b.x)]) == gen, bar);
      __builtin_amdgcn_fence(__ATOMIC_ACQUIRE, "agent");
      asm volatile("s_waitcnt vmcnt(0)" ::: "memory");
    }
  }
  __syncthreads();
}

#ifndef REP_ATTN
#define REP_ATTN 1
#endif
#ifndef REP_G1
#define REP_G1 1
#endif
#ifndef REP_BAR
#define REP_BAR 1
#endif
#ifndef REP_P0
#define REP_P0 1
#endif
#ifndef REP_EW
#define REP_EW 1
#endif
#ifndef REP_G2
#define REP_G2 1
#endif
#ifndef REP_P1
#define REP_P1 1
#endif
#ifndef REP_OUT
#define REP_OUT 1
#endif
#ifndef REP_CONV
#define REP_CONV 1
#endif
#define GSYNC() do { for (int _b = 0; _b < opaque_int(REP_BAR); ++_b) xcd_barrier(xb); } while (0)

__global__ void __launch_bounds__(512, 2) fwd_megakernel(Params p) {
  cg::grid_group grid = cg::this_grid();
  extern __shared__ __attribute__((aligned(16))) char smem_all[];
#define smem (smem_all + (opaque_tid512() >> 8) * LDS_HALF)
  __shared__ uint4 xb_words;
  if (threadIdx.x == 0) xb_words = make_uint4(0u, 0u, 0u, 0u);
  __syncthreads();
  if (p.ws == nullptr) grid.sync();
  XcdBarrier xb = xcd_barrier_post(reinterpret_cast<unsigned*>(p.ws + OFF_BAR), (volatile LAS unsigned*)&xb_words);
  const float* MOD = reinterpret_cast<const float*>(p.ws + OFF_MOD);
  float* X = reinterpret_cast<float*>(p.ws + OFF_X);
  const f16* H = reinterpret_cast<const f16*>(p.ws + OFF_H);
  f16* PROJ = reinterpret_cast<f16*>(p.ws + OFF_PROJ);
  const f16* A2 = reinterpret_cast<const f16*>(p.ws + OFF_A2);

  for (int _r = 0; _r < opaque_int(REP_P0); ++_r) phase0(p, smem);
  GSYNC();
  for (int layer = 0; layer < 4; ++layer) {
    const int j = layer >> 1;
    for (int _r = 0; _r < opaque_int(REP_EW); ++_r) phase_norm(p, layer);
    if (layer == 0) {
      for (int _r = 0; _r < opaque_int(REP_P1); ++_r) phase1(p, smem);
      for (int t = VBID; t < 288; t += VGRID) ada_tile(p, 96 + t, smem);
    }
    GSYNC();
    if ((layer & 1) == 0) {
      {
        const f16* W = reinterpret_cast<const f16*>(p.ws + OFF_WHIN) + (size_t)j * 4096 * 1024;
        if (layer == 0) phase_filter_norm(p);
        EpiStoreT epi{PROJ, 8192};
        for (int _r = 0; _r < opaque_int(REP_G1); ++_r) gemm512<0, 4, 0, 1, 0>(H, 1024, W, 1024, 1024, 32, 32 * 16, blockIdx.x, gridDim.x, smem_all, epi);
      }
      GSYNC();
      for (int _r = 0; _r < opaque_int(REP_CONV); ++_r) phase_hyconv(p, j, smem_all);
      GSYNC();
      {
        const f16* A2T = reinterpret_cast<const f16*>(p.ws + OFF_YT);
        const f16* W = reinterpret_cast<const f16*>(p.ws + OFF_WHOUT) + (size_t)j * 1024 * 1024;
        EpiResid epi{X, MOD + layer * 3 * 3072, layer == 0 ? p.x_prompt : X, layer == 0 ? p.x_sample : X + (size_t)4096 * 1024};
        gemm512<1, 2, 1, 0, 0>(A2T, 8192, W, 1024, 1024, 32, 32 * 8, blockIdx.x, gridDim.x, smem_all, epi);
        for (int _r = 1; _r < opaque_int(REP_OUT); ++_r) gemm512<1, 2, 1, 0, 0>(A2T, 8192, W, 1024, 1024, 32, 32 * 8, blockIdx.x, gridDim.x, smem_all, EpiNull{});
      }
      GSYNC();
    } else {
      {
        const f16* W = reinterpret_cast<const f16*>(p.ws + OFF_WMIN) + (size_t)j * MLA_INP * 1024;
        phase_mlaprep(p, j, 0);
        EpiStoreF16 epi{PROJ, MLA_IN, MLA_IN, 1.f};
        for (int _r = 0; _r < opaque_int(REP_G2); ++_r) gemm512<1, 4, 0, 0, 0>(H, 1024, W, 1024, 1024, 32, 32 * 7, blockIdx.x, gridDim.x, smem_all, epi);
      }
      GSYNC();
      {
        const f16* WQ = reinterpret_cast<const f16*>(p.ws + OFF_WQB) + (size_t)j * 1536 * 384;
        const f16* WKV = reinterpret_cast<const f16*>(p.ws + OFF_WKVB) + (size_t)j * 2048 * 256;
        const f16* CKVC = reinterpret_cast<const f16*>(p.ws + M_CKV) + (size_t)8192 * 256;
        const float qscale = 0.10206207261596577f * 1.4426950408889634f;
        const float* rstdS = reinterpret_cast<const float*>(smem_all + 2 * 65536);
        EpiStoreF16 eq{reinterpret_cast<f16*>(p.ws + M_Q), 1536, 1536, qscale, rstdS};
        EpiKV ekv{p.ws, rstdS};
        for (int _r = 0; _r < opaque_int(REP_G2); ++_r) {
        gemm512<0, 4, 0, 0, 1>(PROJ + 384, MLA_IN, WKV, 256, 256, 36, 36 * 8, blockIdx.x, gridDim.x, smem_all, ekv, CKVC, 256, 32);
        gemm512<1, 4, 0, 0, 1>(PROJ, MLA_IN, WQ, 384, 384, 32, 32 * 6, gridDim.x - 1 - blockIdx.x, gridDim.x, smem_all, eq);
        }
        phase_mlaprep(p, j, 1);
      }
      GSYNC();
      for (int _r = 0; _r < opaque_int(REP_ATTN); ++_r) phase_attn(p, smem_all);
      GSYNC();
      {
        const f16* W = reinterpret_cast<const f16*>(p.ws + OFF_WO) + (size_t)j * 1024 * 1024;
        EpiResid epi{X, MOD + layer * 3 * 3072, layer == 0 ? p.x_prompt : X, layer == 0 ? p.x_sample : X + (size_t)4096 * 1024};
        gemm512<1, 2, 0, 0, 0>(A2, 1024, W, 1024, 1024, 32, 32 * 8, blockIdx.x, gridDim.x, smem_all, epi);
        for (int _r = 1; _r < opaque_int(REP_OUT); ++_r) gemm512<1, 2, 0, 0, 0>(A2, 1024, W, 1024, 1024, 32, 32 * 8, blockIdx.x, gridDim.x, smem_all, EpiNull{});
      }
      GSYNC();
    }
  }
  phase_final(p);
}

#undef smem
extern "C" void kernel_launch(void* const* d_in, const int* in_sizes, int n_in, void* d_out, int out_size,
                              void* d_ws, size_t ws_size, hipStream_t stream) {
  static int grid_blocks = 0;
  if (!grid_blocks) {
    int dev = 0, cus = 0, per_cu = 0;
    hipGetDevice(&dev);
    hipDeviceGetAttribute(&cus, hipDeviceAttributeMultiprocessorCount, dev);
    hipFuncSetAttribute((const void*)fwd_megakernel, hipFuncAttributeMaxDynamicSharedMemorySize, LDS_BYTES);
    hipOccupancyMaxActiveBlocksPerMultiprocessor(&per_cu, fwd_megakernel, 512, LDS_BYTES);
    if (per_cu > 1) per_cu = 1;
    if (per_cu < 1) per_cu = 1;
    grid_blocks = cus * per_cu;
  }
  Params p{};
  const float** pp = reinterpret_cast<const float**>(&p);
  for (int i = 0; i < 27; ++i) pp[i] = reinterpret_cast<const float*>(d_in[i]);
  p.out = reinterpret_cast<float*>(d_out);
  p.ws = reinterpret_cast<char*>(d_ws);
  hipMemsetAsync(p.ws + OFF_BAR, 0, XCD_BAR_WORDS * 4, stream);
  void* args[] = {&p};
  hipError_t e = hipLaunchCooperativeKernel((void*)fwd_megakernel, dim3(grid_blocks), dim3(512), args, LDS_BYTES, stream);
  if (e != hipSuccess) fprintf(stderr, "cooperative launch failed: %s (grid %d)\n", hipGetErrorString(e), grid_blocks);
}
```

```cpp
#include <hip/hip_runtime.h>
#include <hip/hip_cooperative_groups.h>
#include <cstdio>
#include <cstdint>
namespace cg = cooperative_groups;

typedef _Float16 f16;
typedef _Float16 f16x8 __attribute__((ext_vector_type(8)));
typedef _Float16 f16x4 __attribute__((ext_vector_type(4)));
typedef _Float16 f16x2 __attribute__((ext_vector_type(2)));
typedef float f32x4 __attribute__((ext_vector_type(4)));
typedef float f32x2 __attribute__((ext_vector_type(2)));

#define NTOK 8192
#define DM 1024
#define NKV 9216
#define MLA_IN 1696
#define MLA_INP 1792

struct Params {
  const float *x_prompt, *x_sample, *cache_ckv, *cache_kpe, *c, *c_ctx, *norm_w, *ada_w, *ada_b,
      *hy_w_in, *hy_conv_w, *hy_conv_b, *hy_f_w1, *hy_f_b1, *hy_f_freq, *hy_f_w2, *hy_f_b2, *hy_f_w3,
      *hy_f_bias, *hy_w_out, *mla_w_in, *mla_q_norm, *mla_w_qb, *mla_kv_norm, *mla_w_kvb, *mla_w_o,
      *final_norm;
  float* out;
  char* ws;
};

constexpr size_t MB = 1u << 20;
constexpr size_t OFF_X = 0;
constexpr size_t OFF_MOD = 32 * MB;
constexpr size_t OFF_HDN2 = OFF_MOD + 256 * 1024;
constexpr size_t OFF_FSUM = 34 * MB;
constexpr size_t OFF_H = 35 * MB;
constexpr size_t OFF_PROJ = 51 * MB;
constexpr size_t OFF_WHIN = 115 * MB;
constexpr size_t OFF_WHOUT = 131 * MB;
constexpr size_t OFF_WMIN = 135 * MB;
constexpr size_t OFF_WQB = 142 * MB;
constexpr size_t OFF_WKVB = 145 * MB;
constexpr size_t OFF_WO = 147 * MB;
constexpr size_t OFF_FRAW = 151 * MB;
constexpr size_t OFF_ZT = 187 * MB;
constexpr size_t OFF_MG = 203 * MB;
constexpr size_t OFF_YT = 219 * MB;
constexpr size_t OFF_A2 = 235 * MB;
constexpr size_t M_QN = 187 * MB;
constexpr size_t M_CKV = 193 * MB;
constexpr size_t M_KPEP = 198 * MB;
constexpr size_t M_KPES = 198 * MB + 512 * 1024;
constexpr size_t M_Q = 199 * MB;
constexpr size_t M_KNP = 223 * MB;
constexpr size_t M_KNS = 51 * MB + 28 * MB;
constexpr size_t M_VTP = 51 * MB + 38 * MB;
constexpr size_t M_VTS = 51 * MB + 46 * MB;
constexpr size_t OFF_BAR = 251 * MB;
constexpr size_t WS_NEED = 252 * MB;
constexpr int LDS_HALF = 8 * (512 * 16 + 64) + 128 * 80;
constexpr int LDS_BYTES = 2 * LDS_HALF;

__device__ __forceinline__ int opaque_int(int v) { asm volatile("" : "+s"(v)); return v; }
__device__ __forceinline__ int opaque_tid() { int t = threadIdx.x; asm volatile("" : "+v"(t)); return t & 255; }
__device__ __forceinline__ int opaque_tid512() { int t = threadIdx.x; asm volatile("" : "+v"(t)); return t; }
#define VBID ((int)(blockIdx.x * 2 + (opaque_tid512() >> 8)))
#define VGRID ((int)(gridDim.x * 2))
__device__ __forceinline__ float silu_f(float x) { return x / (1.f + __expf(-x)); }
__device__ __forceinline__ float wave_sum(float v) {
#pragma unroll
  for (int o = 32; o > 0; o >>= 1) v += __shfl_xor(v, o);
  return v;
}
__device__ __forceinline__ int tok_cond(int tok) { return tok < 4096 ? 0 : 1 + ((tok - 4096) >> 11); }

typedef __fp16 h16x4_t __attribute__((__vector_size__(4 * sizeof(__fp16))));
__device__ __forceinline__ f16x4 lds_tr_read(const char* lds_ptr) {
  h16x4_t v = __builtin_amdgcn_ds_read_tr16_b64_v4f16((__attribute__((address_space(3))) h16x4_t*)(unsigned)(size_t)lds_ptr);
  f16x4 r;
  __builtin_memcpy(&r, &v, 8);
  return r;
}
template <int SWAP, int NT, int ATR, int APERM, int ASTAT, class Epi>
__device__ __forceinline__ void gemm512(const f16* __restrict__ A, int lda, const f16* __restrict__ Bt, int ldb, int K,
                                        int tilesM, int ntiles, int first, int stride, char* smem, Epi epi,
                                        const f16* __restrict__ A2nd = nullptr, int lda2 = 0, int tmSplit = 1 << 30) {
  constexpr int BN = 64 * NT, BCH = BN / 64, BUF = 32768 + BN * 128;
  const int cnt = first < ntiles ? (ntiles - first + stride - 1) / stride : 0;
  if (cnt == 0) return;
  const int tid = opaque_tid512(), wid = tid >> 6, lane = tid & 63, wr = wid >> 2, wc = wid & 3, fr = lane & 15,
            fq = lane >> 4;
  const int srow = tid >> 3, sc = tid & 7;
  const int woff = srow * 128 + ((sc ^ ((srow >> 1) & 7)) * 16);
  const int fsw = (fr >> 1) & 7;
  constexpr int GSH = NT == 4 ? 4 : 3;
  const int woffB = SWAP ? srow * 128 + ((sc ^ ((((srow >> GSH) & 3) << 1) | ((srow >> 1) & 1))) * 16) : woff;
  const int browl = SWAP ? wc * 16 * NT + (fr >> 2) * 4 * NT + (fr & 3) : wc * 16 * NT + fr;
  const int fswB = SWAP ? (((fr >> 2) & 3) << 1) | ((fr >> 1) & 1) : fsw;
  const int aoff = APERM ? (wr * 128 + (fr >> 2) * 8 + (fr & 3)) * 128 : (wr * 128 + fr) * 128;
  const int fswA = APERM ? ((((fr >> 2) & 3) << 1) | ((fr >> 1) & 1)) : fsw;
  const int boff = 32768 + browl * 128;
  const int skr = tid >> 5, smc = tid & 31;
  const int woffT = skr * 512 + ((smc ^ (2 * ((skr & 3) | (((skr >> 3) & 1) << 2)))) * 16);
  const int trq = (lane & 15) >> 2, trp = lane & 3;
  const int nk = K >> 6, total = cnt * nk;
  f32x4 acc[8][NT];
  f16x8 pa[4], pb[BCH];
  float ssq[4] = {0.f, 0.f, 0.f, 0.f};
  float* rstdS = reinterpret_cast<float*>(smem + 2 * BUF);
#define G5_ISSUE(S_)                                                                          \
  {                                                                                           \
    const int i_ = (S_) / nk, k_ = (S_) - i_ * nk, t_ = first + i_ * stride;                  \
    const int tm_ = t_ % tilesM;                                                              \
    const bool second_ = !ATR && tm_ >= tmSplit;             \
    const int ldq_ = second_ ? lda2 : lda;                                                    \
    const f16* abase_ = second_ ? A2nd + (size_t)(tm_ - tmSplit) * 256 * lda2 : A + (size_t)tm_ * 256 * lda; \
    const f16* ag_ = ATR ? A + (size_t)(k_ * 64 + (tid >> 5)) * lda + (t_ % tilesM) * 256 + (tid & 31) * 8      \
                         : abase_ + (size_t)srow * ldq_ + sc * 8 + k_ * 64;                                     \
    const f16* bg_ = Bt + (size_t)((t_ / tilesM) * BN + srow) * ldb + sc * 8 + k_ * 64;      \
    _Pragma("unroll") for (int q_ = 0; q_ < 4; ++q_) pa[q_] = *reinterpret_cast<const f16x8*>(ag_ + (size_t)((ATR ? 16 : 64) * q_) * ldq_); \
    _Pragma("unroll") for (int q_ = 0; q_ < BCH; ++q_) pb[q_] = *reinterpret_cast<const f16x8*>(bg_ + (size_t)(64 * q_) * ldb); \
  }
#define G5_STORE(BUFI_)                                                                       \
  {                                                                                           \
    char* nb_ = smem + (BUFI_) * BUF;                                                         \
    if (ASTAT) {                                                                              \
      _Pragma("unroll") for (int q_ = 0; q_ < 4; ++q_)                                        \
        _Pragma("unroll") for (int e_ = 0; e_ < 8; e_ += 2) {                                 \
          const f16x2 a_ = {pa[q_][e_], pa[q_][e_ + 1]};                                      \
          ssq[q_] = __builtin_amdgcn_fdot2(a_, a_, ssq[q_], false);                           \
        }                                                                                     \
    }                                                                                         \
    _Pragma("unroll") for (int q_ = 0; q_ < 4; ++q_) *reinterpret_cast<f16x8*>(nb_ + (ATR ? woffT : APERM ? srow * 128 + ((sc ^ ((((srow >> 3) & 3) << 1) | ((srow >> 1) & 1))) * 16) : woff) + q_ * 8192) = pa[q_]; \
    _Pragma("unroll") for (int q_ = 0; q_ < BCH; ++q_) *reinterpret_cast<f16x8*>(nb_ + 32768 + woffB + q_ * 8192) = pb[q_]; \
  }
  G5_ISSUE(0)
  G5_STORE(0)
  __syncthreads();
  for (int s = 0; s < total; ++s) {
    if (s + 1 < total) G5_ISSUE(s + 1)
    const int ti = s / nk, kk = s - ti * nk;
    if (kk == 0) {
#pragma unroll
      for (int m = 0; m < 8; ++m)
#pragma unroll
        for (int n = 0; n < NT; ++n) acc[m][n] = f32x4{0.f, 0.f, 0.f, 0.f};
    }
    const char* buf = smem + (s & 1) * BUF;
    if (NT == 2) {
    f16x8 afA[4], afB[4], bfA[NT];
#define G5_READ_A(DST, KS_, MH_)                                                                                   \
    {                                                                                                              \
      if (ATR) {                                                                                                   \
        _Pragma("unroll") for (int m4 = 0; m4 < 4; ++m4) {                                                         \
          const int m = (MH_) * 4 + m4;                                                                            \
          f16x4 h2[2];                                                                                             \
          _Pragma("unroll") for (int t2 = 0; t2 < 2; ++t2) {                                                       \
            const int krow = 32 * (KS_) + 8 * fq + 4 * t2 + trq;                                                   \
            const int ch = ((wr * 128 + m * 16 + 4 * trp) >> 3) ^ (2 * ((krow & 3) | (((krow >> 3) & 1) << 2)));   \
            h2[t2] = lds_tr_read(buf + krow * 512 + ch * 16 + 8 * (trp & 1));                                      \
          }                                                                                                        \
          DST[m4] = f16x8{h2[0][0], h2[0][1], h2[0][2], h2[0][3], h2[1][0], h2[1][1], h2[1][2], h2[1][3]};          \
        }                                                                                                          \
      } else {                                                                                                     \
        const int coA = ((((KS_) * 4 + fq) ^ fswA) * 16);                                                          \
        _Pragma("unroll") for (int m4 = 0; m4 < 4; ++m4) {                                                         \
          const int m = (MH_) * 4 + m4;                                                                            \
          DST[m4] = *reinterpret_cast<const f16x8*>(buf + aoff + (APERM ? (m >> 1) * 4096 + (m & 1) * 512 : m * 2048) + coA); \
        }                                                                                                          \
      }                                                                                                            \
    }
#define G5_READ_B(DST, KS_)                                                                                        \
    {                                                                                                              \
      const int coB = ((((KS_) * 4 + fq) ^ fswB) * 16);                                                            \
      _Pragma("unroll") for (int n = 0; n < NT; ++n) DST[n] = *reinterpret_cast<const f16x8*>(buf + boff + n * (SWAP ? 512 : 2048) + coB); \
    }
#define G5_MMA(AF, BF, MH_)                                                                                        \
    {                                                                                                              \
      _Pragma("unroll") for (int m4 = 0; m4 < 4; ++m4) _Pragma("unroll") for (int n = 0; n < NT; ++n) {            \
        const int m = (MH_) * 4 + m4;                                                                              \
        if (SWAP) acc[m][n] = __builtin_amdgcn_mfma_f32_16x16x32_f16(BF[n], AF[m4], acc[m][n], 0, 0, 0);           \
        else acc[m][n] = __builtin_amdgcn_mfma_f32_16x16x32_f16(AF[m4], BF[n], acc[m][n], 0, 0, 0);                \
      }                                                                                                            \
    }
    G5_READ_B(bfA, 0)
    G5_READ_A(afA, 0, 0)
    __builtin_amdgcn_sched_barrier(0);
    G5_READ_A(afB, 0, 1)
    __builtin_amdgcn_sched_barrier(0);
    G5_MMA(afA, bfA, 0)
    __builtin_amdgcn_sched_barrier(0);
    G5_READ_A(afA, 1, 0)
    __builtin_amdgcn_sched_barrier(0);
    G5_MMA(afB, bfA, 1)
    __builtin_amdgcn_sched_barrier(0);
    G5_READ_B(bfA, 1)
    G5_READ_A(afB, 1, 1)
    __builtin_amdgcn_sched_barrier(0);
    G5_MMA(afA, bfA, 0)
    __builtin_amdgcn_sched_barrier(0);
    G5_MMA(afB, bfA, 1)
    __builtin_amdgcn_sched_barrier(0);
#undef G5_READ_A
#undef G5_READ_B
#undef G5_MMA
    } else {
#pragma unroll
    for (int ks = 0; ks < 2; ++ks) {
      f16x8 af[4], bf[NT];
      const int co = (((ks * 4 + fq) ^ fsw) * 16);
      const int coB = (((ks * 4 + fq) ^ fswB) * 16);
#pragma unroll
      for (int n = 0; n < NT; ++n) bf[n] = *reinterpret_cast<const f16x8*>(buf + boff + n * (SWAP ? 512 : 2048) + coB);
#pragma unroll
      for (int mh = 0; mh < 2; ++mh) {
        if (ATR) {
#pragma unroll
          for (int m4 = 0; m4 < 4; ++m4) {
            const int m = mh * 4 + m4;
            f16x4 h2[2];
#pragma unroll
            for (int t2 = 0; t2 < 2; ++t2) {
              const int krow = 32 * ks + 8 * fq + 4 * t2 + trq;
              const int ch = ((wr * 128 + m * 16 + 4 * trp) >> 3) ^ (2 * ((krow & 3) | (((krow >> 3) & 1) << 2)));
              h2[t2] = lds_tr_read(buf + krow * 512 + ch * 16 + 8 * (trp & 1));
            }
            af[m4] = f16x8{h2[0][0], h2[0][1], h2[0][2], h2[0][3], h2[1][0], h2[1][1], h2[1][2], h2[1][3]};
          }
        } else {
          const int coA = (((ks * 4 + fq) ^ fswA) * 16);
#pragma unroll
          for (int m4 = 0; m4 < 4; ++m4) {
            const int m = mh * 4 + m4;
            af[m4] = *reinterpret_cast<const f16x8*>(buf + aoff + (APERM ? (m >> 1) * 4096 + (m & 1) * 512 : m * 2048) + coA);
          }
        }
        __builtin_amdgcn_sched_barrier(0);
#pragma unroll
        for (int m4 = 0; m4 < 4; ++m4)
#pragma unroll
          for (int n = 0; n < NT; ++n) {
            const int m = mh * 4 + m4;
            if (SWAP) acc[m][n] = __builtin_amdgcn_mfma_f32_16x16x32_f16(bf[n], af[m4], acc[m][n], 0, 0, 0);
            else acc[m][n] = __builtin_amdgcn_mfma_f32_16x16x32_f16(af[m4], bf[n], acc[m][n], 0, 0, 0);
          }
        __builtin_amdgcn_sched_barrier(0);
      }
    }
    }
    if (ASTAT && kk == nk - 1) {
      const int t_ = first + ti * stride;
      const bool cacheRows = (t_ % tilesM) >= tmSplit;
#pragma unroll
      for (int q = 0; q < 4; ++q) {
        float v = ssq[q];
        v += __shfl_xor(v, 1); v += __shfl_xor(v, 2); v += __shfl_xor(v, 4);
        if (sc == 0) rstdS[srow + 64 * q] = cacheRows ? 1.f : rsqrtf(v / (float)K + 1e-6f);
        ssq[q] = 0.f;
      }
    }
    if (s + 1 < total) G5_STORE((s + 1) & 1)
    __syncthreads();
    if (kk == nk - 1) {
      const int t_ = first + ti * stride;
      const int brow = (t_ % tilesM) * 256, bcol = (t_ / tilesM) * BN;
      if (APERM) {
#pragma unroll
        for (int n = 0; n < NT; ++n) {
          f32x4 cv[8];
#pragma unroll
          for (int m = 0; m < 8; ++m) cv[m] = acc[m][n];
          epi.colT(bcol + wc * 16 * NT + n * 16 + fr, brow + wr * 128 + fq * 8, cv);
        }
      } else if (SWAP) {
#pragma unroll
        for (int m = 0; m < 8; ++m) epi.row(brow + wr * 128 + m * 16 + fr, bcol + wc * 16 * NT + fq * 4 * NT, acc[m]);
      } else {
#pragma unroll
        for (int m = 0; m < 8; ++m)
#pragma unroll
          for (int n = 0; n < NT; ++n) epi(brow + wr * 128 + m * 16, bcol + wc * 16 * NT + n * 16, fr, fq, acc[m][n]);
      }
    }
  }
#undef G5_ISSUE
#undef G5_STORE
}

__device__ __forceinline__ void convert_tile(const float* __restrict__ src, f16* __restrict__ dst, int K, int N, int tile,
                             char* smem, const float* __restrict__ kscale = nullptr) {
  f16(*T)[136] = reinterpret_cast<f16(*)[136]>(smem);
  const int tid = opaque_tid();
  const int nkt = K >> 7;
  const int k0 = (tile % nkt) * 128, n0 = (tile / nkt) * 64;
  const int kk = tid >> 4, nn4 = (tid & 15) * 4;
  float4 vv[8];
#pragma unroll
  for (int i = 0; i < 8; ++i) {
    const int k = k0 + kk + 16 * i, n = n0 + nn4;
    vv[i] = make_float4(0.f, 0.f, 0.f, 0.f);
    if (n < N) {
      const float* sp_ = src + (size_t)k * N + n;
      vv[i].x = __builtin_nontemporal_load(sp_); vv[i].y = __builtin_nontemporal_load(sp_ + 1);
      vv[i].z = __builtin_nontemporal_load(sp_ + 2); vv[i].w = __builtin_nontemporal_load(sp_ + 3);
    }
  }
#pragma unroll
  for (int i = 0; i < 8; ++i) {
    const int k = k0 + kk + 16 * i;
    float4 v = vv[i];
    if (kscale) { const float g = kscale[k]; v.x *= g; v.y *= g; v.z *= g; v.w *= g; }
    T[nn4 + 0][kk + 16 * i] = (f16)v.x;
    T[nn4 + 1][kk + 16 * i] = (f16)v.y;
    T[nn4 + 2][kk + 16 * i] = (f16)v.z;
    T[nn4 + 3][kk + 16 * i] = (f16)v.w;
  }
  __syncthreads();
  const int n = tid >> 2, ks = (tid & 3) * 32;
  f16* d = dst + (size_t)(n0 + n) * K + k0 + ks;
#pragma unroll
  for (int q = 0; q < 4; ++q) *reinterpret_cast<f16x8*>(d + 8 * q) = *reinterpret_cast<const f16x8*>(&T[n][ks + 8 * q]);
  __syncthreads();
}

__device__ __forceinline__ void ada_tile(const Params& p, int tile, char* smem) {
  float* s = reinterpret_cast<float*>(smem);
  float* red = s + 3072;
  const int tid = opaque_tid();
  const int layer = tile / 96, cgp = tile % 96;
  for (int i = tid; i < 3072; i += 256) {
    int cnd = i >> 10, k = i & 1023;
    float v = cnd == 0 ? p.c_ctx[k] : p.c[(cnd - 1) * 1024 + k];
    s[i] = silu_f(v);
  }
  __syncthreads();
  const int cq = tid & 7, kg = tid >> 3;
  const float* W = p.ada_w + (size_t)layer * 1024 * 3072 + cgp * 32 + cq * 4;
  float4 a0 = make_float4(0.f, 0.f, 0.f, 0.f), a1 = a0, a2 = a0;
#pragma unroll 8
  for (int k = kg * 32; k < kg * 32 + 32; ++k) {
    const float* wp_ = W + (size_t)k * 3072;
    const float4 w = make_float4(__builtin_nontemporal_load(wp_), __builtin_nontemporal_load(wp_ + 1), __builtin_nontemporal_load(wp_ + 2), __builtin_nontemporal_load(wp_ + 3));
    const float s0 = s[k], s1 = s[1024 + k], s2 = s[2048 + k];
    a0.x += s0 * w.x; a0.y += s0 * w.y; a0.z += s0 * w.z; a0.w += s0 * w.w;
    a1.x += s1 * w.x; a1.y += s1 * w.y; a1.z += s1 * w.z; a1.w += s1 * w.w;
    a2.x += s2 * w.x; a2.y += s2 * w.y; a2.z += s2 * w.z; a2.w += s2 * w.w;
  }
  *reinterpret_cast<float4*>(red + (kg * 3 + 0) * 32 + cq * 4) = a0;
  *reinterpret_cast<float4*>(red + (kg * 3 + 1) * 32 + cq * 4) = a1;
  *reinterpret_cast<float4*>(red + (kg * 3 + 2) * 32 + cq * 4) = a2;
  __syncthreads();
  if (tid < 96) {
    const int cnd = tid >> 5, c2 = tid & 31;
    float v = p.ada_b[layer * 3072 + cgp * 32 + c2];
#pragma unroll
    for (int q = 0; q < 32; ++q) v += red[(q * 3 + cnd) * 32 + c2];
    reinterpret_cast<float*>(p.ws + OFF_MOD)[(layer * 3 + cnd) * 3072 + cgp * 32 + c2] = v;
  }
  __syncthreads();
}

__device__ __forceinline__ void hidden_tile(const Params& p, int tile, char* smem) {
  float* z = reinterpret_cast<float*>(smem);
  float* h1 = z + 4 * 36;
  const int tid = opaque_tid(), w = tid >> 6, o = tid & 63;
  const int j = tile / 576, r = (tile % 576) * 4 + w;
  const int L = r < 256 ? 256 : 2048, ti = r < 256 ? r : r - 256;
  if (o < 33) {
    float v;
    if (o == 0) {
      v = (float)ti / (float)(L - 1);
    } else {
      int bi = (o - 1) & 15;
      float band = 1e-4f + (float)bi * ((15.0f - 1e-4f) / 15.0f);
      float wang = (6.283185307179586f / (float)L) * (float)ti;
      float ang = band * wang;
      v = (o <= 16) ? cosf(ang) : -sinf(ang);
    }
    z[w * 36 + o] = v;
  }
  __syncthreads();
  const float fr = p.hy_f_freq[j * 64 + o];
  float a = p.hy_f_b1[j * 64 + o];
  for (int e = 0; e < 33; ++e) a += z[w * 36 + e] * p.hy_f_w1[(j * 33 + e) * 64 + o];
  h1[w * 64 + o] = sinf(fr * a);
  __syncthreads();
  a = p.hy_f_b2[j * 64 + o];
  for (int k = 0; k < 64; ++k) a += h1[w * 64 + k] * p.hy_f_w2[(j * 64 + k) * 64 + o];
  reinterpret_cast<float*>(p.ws + OFF_HDN2)[((size_t)j * 2304 + r) * 64 + o] = sinf(fr * a);
  __syncthreads();
}

__device__ __forceinline__ void phase0(const Params& p, char* smem) {
  const int T_ADA = 96, T_HID = 1152, T_XC = 0, T_CV = 2256;
  const int total = T_ADA + T_HID + T_XC + T_CV;
  for (int t = VBID; t < total; t += VGRID) {
    if (t < T_ADA) {
      ada_tile(p, t, smem);
    } else if (t < T_ADA + T_HID) {
      hidden_tile(p, t - T_ADA, smem);
    } else if (t < T_ADA + T_HID + T_XC) {
      int tt = t - T_ADA - T_HID;
      float4* X = reinterpret_cast<float4*>(p.ws + OFF_X);
#pragma unroll
      for (int i = 0; i < 4; ++i) {
        size_t idx = (size_t)tt * 1024 + i * 256 + (threadIdx.x & 255);
        const float4* src = idx < (1u << 20) ? reinterpret_cast<const float4*>(p.x_prompt) + idx
                                             : reinterpret_cast<const float4*>(p.x_sample) + (idx - (1u << 20));
        X[idx] = *src;
      }
      __syncthreads(); __syncthreads(); __syncthreads();
    } else {
      int tt = t - T_ADA - T_HID - T_XC;
      const int j = tt / 1128;
      int u = tt % 1128;
      if (u < 512) {
        convert_tile(p.hy_w_in + (size_t)j * 1024 * 4096, reinterpret_cast<f16*>(p.ws + OFF_WHIN) + (size_t)j * 4096 * 1024, 1024, 4096, u, smem);
      } else if (u < 640) {
        convert_tile(p.hy_w_out + (size_t)j * 1024 * 1024, reinterpret_cast<f16*>(p.ws + OFF_WHOUT) + (size_t)j * 1024 * 1024, 1024, 1024, u - 512, smem);
      } else if (u < 864) {
        convert_tile(p.mla_w_in + (size_t)j * 1024 * MLA_IN, reinterpret_cast<f16*>(p.ws + OFF_WMIN) + (size_t)j * MLA_INP * 1024, 1024, MLA_IN, u - 640, smem);
      } else if (u < 936) {
        convert_tile(p.mla_w_qb + (size_t)j * 384 * 1536, reinterpret_cast<f16*>(p.ws + OFF_WQB) + (size_t)j * 1536 * 384, 384, 1536, u - 864, smem, p.mla_q_norm + j * 384);
      } else if (u < 1000) {
        convert_tile(p.mla_w_kvb + (size_t)j * 256 * 2048, reinterpret_cast<f16*>(p.ws + OFF_WKVB) + (size_t)j * 2048 * 256, 256, 2048, u - 936, smem, p.mla_kv_norm + j * 256);
      } else {
        convert_tile(p.mla_w_o + (size_t)j * 1024 * 1024, reinterpret_cast<f16*>(p.ws + OFF_WO) + (size_t)j * 1024 * 1024, 1024, 1024, u - 1000, smem);
      }
      __syncthreads();
    }
  }
}

typedef float f32x16 __attribute__((ext_vector_type(16)));
__device__ __forceinline__ void phase1(const Params& p, char* smem) {
  float* red = reinterpret_cast<float*>(smem);
  const int tid = opaque_tid(), w = tid >> 6, lane = tid & 63, r = lane & 31, hh = lane >> 5;
  const float* HD = reinterpret_cast<const float*>(p.ws + OFF_HDN2);
  float* G2 = reinterpret_cast<float*>(p.ws + OFF_FRAW);
  float* G1 = G2 + (size_t)2 * 1024 * 4096;
  float* FSUM = reinterpret_cast<float*>(p.ws + OFF_FSUM);
  for (int t = VGRID - 1 - VBID; t < 576; t += VGRID) {
    const int j = t / 288, u = t % 288, tch = u >> 5, cgp = u & 31;
    const int L = tch == 0 ? 256 : 2048;
    const int ti0 = (tch == 0 ? 0 : (tch - 1) * 256) + w * 64;
    const int row0 = (tch == 0 ? 0 : 256) + ti0;
    f16x8 af[2][4], bf[2][4];
#pragma unroll
    for (int rt = 0; rt < 2; ++rt)
#pragma unroll
      for (int ks = 0; ks < 4; ++ks) {
        const float* ap = HD + ((size_t)j * 2304 + row0 + rt * 32 + r) * 64 + ks * 16 + hh * 8;
        const float4 x0 = *reinterpret_cast<const float4*>(ap), x1 = *reinterpret_cast<const float4*>(ap + 4);
        af[rt][ks] = f16x8{(f16)x0.x, (f16)x0.y, (f16)x0.z, (f16)x0.w, (f16)x1.x, (f16)x1.y, (f16)x1.z, (f16)x1.w};
      }
#pragma unroll
    for (int ct = 0; ct < 2; ++ct)
#pragma unroll
      for (int ks = 0; ks < 4; ++ks)
#pragma unroll
        for (int jj = 0; jj < 8; ++jj)
          bf[ct][ks][jj] = (f16)p.hy_f_w3[((size_t)j * 64 + ks * 16 + hh * 8 + jj) * 2048 + cgp * 64 + ct * 32 + r];
    f32x16 acc[2][2];
#pragma unroll
    for (int rt = 0; rt < 2; ++rt)
#pragma unroll
      for (int ct = 0; ct < 2; ++ct) {
#pragma unroll
        for (int q = 0; q < 16; ++q) acc[rt][ct][q] = 0.f;
#pragma unroll
        for (int ks = 0; ks < 4; ++ks) acc[rt][ct] = __builtin_amdgcn_mfma_f32_32x32x16_f16(af[rt][ks], bf[ct][ks], acc[rt][ct], 0, 0, 0);
      }
    const float min_decay = -3.0701134573253945f, max_decay = -15.350567286626973f;
    const float invLm1 = 1.0f / (float)(L - 1);
#pragma unroll
    for (int ct = 0; ct < 2; ++ct) {
      const int col = cgp * 64 + ct * 32 + r, c = col & 1023;
      const bool fwd = col < 1024;
      const float delta = fabsf(min_decay + (float)c * ((max_decay - min_decay) / 1023.0f));
      float* Gc = L == 2048 ? G2 + ((size_t)j * 1024 + c) * 4096 : G1 + ((size_t)j * 1024 + c) * 512;
      float sa = 0.f;
#pragma unroll
      for (int rt = 0; rt < 2; ++rt)
#pragma unroll
        for (int g4 = 0; g4 < 4; ++g4) {
          const int tib = ti0 + rt * 32 + 8 * g4 + 4 * hh;
          float hv[4];
#pragma unroll
          for (int q = 0; q < 4; ++q) {
            const float tt = (float)(tib + q) * invLm1;
            hv[q] = acc[rt][ct][g4 * 4 + q] * __expf(-tt * delta);
            sa += fabsf(hv[q]);
          }
          if (fwd) {
            *reinterpret_cast<float4*>(Gc + L + tib) = make_float4(hv[0], hv[1], hv[2], hv[3]);
          } else {
#pragma unroll
            for (int q = 0; q < 4; ++q) { const int ti = tib + q; Gc[ti == 0 ? 0 : L - ti] = hv[q]; }
          }
        }
      sa += __shfl_xor(sa, 32);
      if (hh == 0) red[w * 64 + ct * 32 + r] = sa;
    }
    __syncthreads();
    if (tid < 64) FSUM[((size_t)j * 9 + tch) * 2048 + cgp * 64 + tid] = red[tid] + red[64 + tid] + red[128 + tid] + red[192 + tid];
    __syncthreads();
  }
}

__device__ __forceinline__ void phase_norm(const Params& p, int layer) {
  const int tid = opaque_tid(), w = tid >> 6, lane = tid & 63;
  const float4* X = reinterpret_cast<const float4*>(p.ws + OFF_X);
  const float* MOD = reinterpret_cast<const float*>(p.ws + OFF_MOD);
  f16* H = reinterpret_cast<f16*>(p.ws + OFF_H);
  const float4* nw = reinterpret_cast<const float4*>(p.norm_w + layer * 1024);
  for (int t = VBID; t < 2048; t += VGRID) {
    const int row = t * 4 + w;
    const int cnd = tok_cond(row);
    const float4* xr = X + (size_t)row * 256;
    if (layer == 0) xr = row < 4096 ? reinterpret_cast<const float4*>(p.x_prompt) + (size_t)row * 256
                                    : reinterpret_cast<const float4*>(p.x_sample) + (size_t)(row - 4096) * 256;
    const float4* sh = reinterpret_cast<const float4*>(MOD + (layer * 3 + cnd) * 3072);
    const float4* sc = sh + 256;
    float4 v[4];
    float ss = 0.f;
#pragma unroll
    for (int i = 0; i < 4; ++i) {
      v[i] = xr[lane + 64 * i];
      ss += v[i].x * v[i].x + v[i].y * v[i].y + v[i].z * v[i].z + v[i].w * v[i].w;
    }
    ss = wave_sum(ss);
    const float rstd = rsqrtf(ss * (1.f / 1024.f) + 1e-6f);
#pragma unroll
    for (int i = 0; i < 4; ++i) {
      const int q = lane + 64 * i;
      float4 g = nw[q], a = sc[q], b = sh[q];
      f16x4 o;
      o[0] = (f16)(v[i].x * rstd * g.x * (1.f + a.x) + b.x);
      o[1] = (f16)(v[i].y * rstd * g.y * (1.f + a.y) + b.y);
      o[2] = (f16)(v[i].z * rstd * g.z * (1.f + a.z) + b.z);
      o[3] = (f16)(v[i].w * rstd * g.w * (1.f + a.w) + b.w);
      *reinterpret_cast<f16x4*>(H + (size_t)row * 1024 + q * 4) = o;
    }
  }
}

struct EpiStoreF16 {
  f16* C; int ldc; int N; float scale; const float* rstdS = nullptr;
  __device__ __forceinline__ void colT(int, int, const f32x4 (&)[8]) const {}
  template <int NT>
  __device__ __forceinline__ void row(int row, int col0, const f32x4 (&v)[NT]) const {
    if (col0 < N) {
      const float sc_ = rstdS ? scale * rstdS[row & 255] : scale;
#pragma unroll
      for (int h = 0; h < NT / 2; ++h) {
        f16x8 o;
#pragma unroll
        for (int q = 0; q < 4; ++q) { o[q] = (f16)(v[2 * h][q] * sc_); o[4 + q] = (f16)(v[2 * h + 1][q] * sc_); }
        *reinterpret_cast<f16x8*>(C + (size_t)row * ldc + col0 + 8 * h) = o;
      }
    }
  }
  __device__ __forceinline__ void operator()(int rb, int cb, int fr, int fq, f32x4 a) const {
    int row = rb + fr, col = cb + fq * 4;
    if (col < N) {
      f16x4 o;
      o[0] = (f16)(a[0] * scale); o[1] = (f16)(a[1] * scale); o[2] = (f16)(a[2] * scale); o[3] = (f16)(a[3] * scale);
      *reinterpret_cast<f16x4*>(C + (size_t)row * ldc + col) = o;
    }
  }
};
struct EpiResid {
  float* X; const float* MODL;
  const float* srcP; const float* srcS;
  __device__ __forceinline__ void colT(int, int, const f32x4 (&)[8]) const {}
  template <int NT>
  __device__ __forceinline__ void row(int row, int col0, const f32x4 (&v)[NT]) const {
    const float* gp = MODL + tok_cond(row) * 3072 + 2048 + col0;
    float* xp = X + (size_t)row * 1024 + col0;
    const float* sp = row < 4096 ? srcP + (size_t)row * 1024 + col0 : srcS + (size_t)(row - 4096) * 1024 + col0;
#pragma unroll
    for (int n = 0; n < NT; ++n) {
      const float4 g = *reinterpret_cast<const float4*>(gp + 4 * n);
      float4 x = *reinterpret_cast<const float4*>(sp + 4 * n);
      x.x += g.x * v[n][0]; x.y += g.y * v[n][1]; x.z += g.z * v[n][2]; x.w += g.w * v[n][3];
      *reinterpret_cast<float4*>(xp + 4 * n) = x;
    }
  }
  __device__ __forceinline__ void operator()(int rb, int cb, int fr, int fq, f32x4 a) const {
    int row = rb + fr, col = cb + fq * 4;
    const float4 g = *reinterpret_cast<const float4*>(MODL + tok_cond(row) * 3072 + 2048 + col);
    float4* xp = reinterpret_cast<float4*>(X + (size_t)row * 1024 + col);
    const float* sp = row < 4096 ? srcP + (size_t)row * 1024 + col : srcS + (size_t)(row - 4096) * 1024 + col;
    float4 x = *reinterpret_cast<const float4*>(sp);
    x.x += g.x * a[0]; x.y += g.y * a[1]; x.z += g.z * a[2]; x.w += g.w * a[3];
    *xp = x;
  }
};
struct EpiStoreT {
  f16* CT; int ldt;
  __device__ __forceinline__ void colT(int col, int t0, const f32x4 (&v)[8]) const {
#pragma unroll
    for (int h = 0; h < 4; ++h) {
      f16x8 o;
#pragma unroll
      for (int q = 0; q < 4; ++q) { o[q] = (f16)v[2 * h][q]; o[4 + q] = (f16)v[2 * h + 1][q]; }
      *reinterpret_cast<f16x8*>(CT + (size_t)col * ldt + t0 + 32 * h) = o;
    }
  }
  template <int NT>
  __device__ __forceinline__ void row(int, int, const f32x4 (&)[NT]) const {}
  __device__ __forceinline__ void operator()(int, int, int, int, f32x4) const {}
};
struct EpiNull {
  __device__ __forceinline__ void colT(int, int, const f32x4 (&)[8]) const {}
  template <int NT>
  __device__ __forceinline__ void row(int row, int col0, const f32x4 (&v)[NT]) const {
#pragma unroll
    for (int n = 0; n < NT; ++n) asm volatile("" :: "v"(v[n][0]), "v"(v[n][1]), "v"(v[n][2]), "v"(v[n][3]));
  }
  __device__ __forceinline__ void operator()(int rb, int cb, int fr, int fq, f32x4 a) const { asm volatile("" :: "v"(a[0]), "v"(a[1]), "v"(a[2]), "v"(a[3])); }
};
struct EpiKV {
  char* ws; const float* rstdS;
  __device__ __forceinline__ void colT(int, int, const f32x4 (&)[8]) const {}
  template <int NT>
  __device__ __forceinline__ void row(int, int, const f32x4 (&)[NT]) const {}
  __device__ __forceinline__ void operator()(int rb, int cb, int fr, int fq, f32x4 a) const {
    const int r0 = rb + fq * 4, n = cb + fr;
    const int h = n >> 7, e = n & 127;
    int b, key;
    const bool pr = r0 < 4096;
    if (pr) { b = r0 >> 8; key = r0 & 255; }
    else if (r0 < 8192) { b = (r0 - 4096) >> 11; key = (r0 - 4096) & 2047; }
    else { b = (r0 - 8192) >> 9; key = 2048 + ((r0 - 8192) & 511); }
    const size_t Lk = pr ? 256 : 2560;
    const size_t bh = (size_t)b * 16 + h;
    const f32x4 rs = *reinterpret_cast<const f32x4*>(rstdS + (r0 & 255));
    a = a * rs;
    if (e < 64) {
      f16* KN = reinterpret_cast<f16*>(ws + (pr ? M_KNP : M_KNS));
#pragma unroll
      for (int j = 0; j < 4; ++j) KN[(bh * Lk + key + j) * 64 + e] = (f16)a[j];
    } else {
      f16* VT = reinterpret_cast<f16*>(ws + (pr ? M_VTP : M_VTS));
      f16x4 o;
      o[0] = (f16)a[0]; o[1] = (f16)a[1]; o[2] = (f16)a[2]; o[3] = (f16)a[3];
      *reinterpret_cast<f16x4*>(VT + (bh * 64 + (e - 64)) * Lk + key) = o;
    }
  }
};

__device__ __forceinline__ void hy_u8(const f16* __restrict__ rowp, int tq, bool hm, bool hp, float w0, float w1, float w2, float bb, float (&u)[8]) {
  const f16x8 cur = *reinterpret_cast<const f16x8*>(rowp + tq);
  const float pm = hm ? (float)rowp[tq - 1] : 0.f, pn = hp ? (float)rowp[tq + 8] : 0.f;
  float x[10];
  x[0] = pm; x[9] = pn;
#pragma unroll
  for (int e = 0; e < 8; ++e) x[1 + e] = (float)cur[e];
#pragma unroll
  for (int e = 0; e < 8; ++e) u[e] = bb + w0 * x[e] + w1 * x[e + 1] + w2 * x[e + 2];
}
__device__ __forceinline__ void hy_u8s(const f16* __restrict__ rowp, int tq, bool hm, bool hp, int lane, float w0, float w1, float w2, float bb, float (&u)[8],
                                       const f16x8* pre = nullptr) {
  const f16x8 cur = pre ? *pre : *reinterpret_cast<const f16x8*>(rowp + tq);
  float pm = __shfl_up((float)cur[7], 1), pn = __shfl_down((float)cur[0], 1);
  if (lane == 0) pm = hm ? (float)rowp[tq - 1] : 0.f;
  if (lane == 63) pn = hp ? (float)rowp[tq + 8] : 0.f;
  if (!hm) pm = 0.f;
  if (!hp) pn = 0.f;
  float x[10];
  x[0] = pm; x[9] = pn;
#pragma unroll
  for (int e = 0; e < 8; ++e) x[1 + e] = (float)cur[e];
#pragma unroll
  for (int e = 0; e < 8; ++e) u[e] = bb + w0 * x[e] + w1 * x[e + 1] + w2 * x[e + 2];
}
__device__ __forceinline__ void phase_hyprep(const Params& p, int j, char* smem) {
  const int tid = opaque_tid();
  const f16* PT = reinterpret_cast<const f16*>(p.ws + OFF_PROJ);
  f16* ZT = reinterpret_cast<f16*>(p.ws + OFF_ZT);
  f16* MG = reinterpret_cast<f16*>(p.ws + OFF_MG);
  const float* cw = p.hy_conv_w + (size_t)j * 3 * 3072;
  const float* cb = p.hy_conv_b + (size_t)j * 3072;
  for (int t = VBID; t < 4096; t += VGRID) {
    const int c = t >> 2, tq = (t & 3) * 2048 + tid * 8;
    const int L = tq < 4096 ? 256 : 2048;
    const bool hm = (tq & (L - 1)) != 0, hp = ((tq + 8) & (L - 1)) != 0;
    float u0[8], u1[8], u2[8];
    hy_u8(PT + (size_t)c * 8192, tq, hm, hp, cw[c], cw[3072 + c], cw[6144 + c], cb[c], u0);
    hy_u8(PT + (size_t)(1024 + c) * 8192, tq, hm, hp, cw[1024 + c], cw[3072 + 1024 + c], cw[6144 + 1024 + c], cb[1024 + c], u1);
    hy_u8(PT + (size_t)(2048 + c) * 8192, tq, hm, hp, cw[2048 + c], cw[3072 + 2048 + c], cw[6144 + 2048 + c], cb[2048 + c], u2);
    const f16x8 g = *reinterpret_cast<const f16x8*>(PT + (size_t)(3072 + c) * 8192 + tq);
    f16x8 zo, mo;
#pragma unroll
    for (int e = 0; e < 8; ++e) {
      zo[e] = (f16)(u2[e] * u1[e]);
      mo[e] = (f16)(u0[e] * silu_f((float)g[e]));
    }
    *reinterpret_cast<f16x8*>(ZT + (size_t)c * 8192 + tq) = zo;
    *reinterpret_cast<f16x8*>(MG + (size_t)c * 8192 + tq) = mo;
  }
}

#define GSCALE 256.0f
__device__ __forceinline__ void phase_filter_norm(const Params& p) {
  const int tid = opaque_tid();
  float* GB = reinterpret_cast<float*>(p.ws + OFF_FRAW);
  const float* FS = reinterpret_cast<const float*>(p.ws + OFF_FSUM);
  for (int t = VBID; t < 2048; t += VGRID) {
    const int j = t >> 10, c = t & 1023;
    const float* FSUM = FS + (size_t)j * 9 * 2048;
    float sf2 = 0.f, sb2 = 0.f;
#pragma unroll
    for (int q = 1; q < 9; ++q) { sf2 += FSUM[q * 2048 + c]; sb2 += FSUM[q * 2048 + 1024 + c]; }
    const float sf1 = FSUM[c], sb1 = FSUM[1024 + c];
    const float bias = p.hy_f_bias[j * 1024 + c] * GSCALE;
    {
      float* G = GB + ((size_t)j * 1024 + c) * 4096;
      const float isf = GSCALE / sf2, isb = GSCALE / sb2;
      const float g0 = G[2048] * isf + G[0] * isb + bias;
      float4 v[4];
#pragma unroll
      for (int i = 0; i < 4; ++i) v[i] = reinterpret_cast<const float4*>(G)[tid + 256 * i];
      __syncthreads();
#pragma unroll
      for (int i = 0; i < 4; ++i) {
        const int q = tid + 256 * i;
        const float sc = q >= 512 ? isf : isb;
        float4 o = make_float4(v[i].x * sc, v[i].y * sc, v[i].z * sc, v[i].w * sc);
        if (q == 0) o.x = 0.f;
        if (q == 512) o.x = g0;
        reinterpret_cast<float4*>(G)[q] = o;
      }
    }
    {
      float* G = GB + (size_t)2 * 1024 * 4096 + ((size_t)j * 1024 + c) * 512;
      const float isf = GSCALE / sf1, isb = GSCALE / sb1;
      const float g0 = G[256] * isf + G[0] * isb + bias;
      float4 v = make_float4(0.f, 0.f, 0.f, 0.f);
      if (tid < 128) v = reinterpret_cast<const float4*>(G)[tid];
      __syncthreads();
      if (tid < 128) {
        const float sc = tid >= 64 ? isf : isb;
        float4 o = make_float4(v.x * sc, v.y * sc, v.z * sc, v.w * sc);
        if (tid == 0) o.x = 0.f;
        if (tid == 64) o.x = g0;
        reinterpret_cast<float4*>(G)[tid] = o;
      }
    }
  }
}

template <int L>
__device__ __forceinline__ void hyconv_pass(const Params& p, int j, int c, char* smem, int tid) {
  constexpr int NB = L / 32, QOFF = NB * 4, NQ = NB * 8, CS = NQ * 16 + 64;
  char* Gs = smem;
  char* Zs = smem + 8 * CS;
  const int w = tid >> 6, lane = tid & 63, r = lane & 31, hh = lane >> 5;
  const float* G = reinterpret_cast<const float*>(p.ws + OFF_FRAW) +
                   (L == 2048 ? ((size_t)j * 1024 + c) * 4096 : (size_t)2 * 1024 * 4096 + ((size_t)j * 1024 + c) * 512);
  f16* YT = reinterpret_cast<f16*>(p.ws + OFF_YT) + (size_t)c * 8192 + (L == 2048 ? 4096 : 0);
  f16* g16 = reinterpret_cast<f16*>(Zs);
  const int tokg = L == 2048 ? 4096 : 0;
  const f16* PT = reinterpret_cast<const f16*>(p.ws + OFF_PROJ);
  const f16* rx0 = PT + (size_t)c * 8192 + tokg;
  const f16* rx1 = PT + (size_t)(1024 + c) * 8192 + tokg;
  const f16* rv = PT + (size_t)(2048 + c) * 8192 + tokg;
  const f16* rg = PT + (size_t)(3072 + c) * 8192 + tokg;
  const float* cw = p.hy_conv_w + (size_t)j * 3 * 3072;
  const float* cb = p.hy_conv_b + (size_t)j * 3072;
  int b, i, dlo, dhi;
  if (L == 2048) { b = r >> 4; i = 16 * w + (r & 15); dlo = 16 * w - 63; dhi = 16 * w + 15; }
  else { const int n = w * 32 + r; b = n >> 3; i = n & 7; dlo = -7; dhi = 7; }
  f16x4 mgv[4];
  {
    const float w0 = cw[c], w1 = cw[3072 + c], w2 = cw[6144 + c], bb0 = cb[c];
#pragma unroll
    for (int g4 = 0; g4 < 4; ++g4) {
      const int to = b * L + 32 * i + 8 * g4 + 4 * hh;
      const f16x4 xc = *reinterpret_cast<const f16x4*>(rx0 + to);
      const f16x4 gv = *reinterpret_cast<const f16x4*>(rg + to);
      float x[6];
      x[0] = (to & (L - 1)) != 0 ? (float)rx0[to - 1] : 0.f;
      x[5] = ((to + 4) & (L - 1)) != 0 ? (float)rx0[to + 4] : 0.f;
#pragma unroll
      for (int q = 0; q < 4; ++q) x[1 + q] = (float)xc[q];
#pragma unroll
      for (int q = 0; q < 4; ++q)
        mgv[g4][q] = (f16)((bb0 + w0 * x[q] + w1 * x[q + 1] + w2 * x[q + 2]) * silu_f((float)gv[q]) * (1.0f / GSCALE) * 16.0f);
    }
  }
  f16x8 zreg[2];
#pragma unroll
  for (int q2 = 0; q2 < 2; ++q2) {
    const int u0 = (tid + 256 * q2) * 8;
    const bool hm = (u0 & (L - 1)) != 0, hp = ((u0 + 8) & (L - 1)) != 0;
    float u1[8], u2[8];
    hy_u8s(rx1, u0, hm, hp, lane, cw[1024 + c], cw[3072 + 1024 + c], cw[6144 + 1024 + c], cb[1024 + c], u1);
    hy_u8s(rv, u0, hm, hp, lane, cw[2048 + c], cw[3072 + 2048 + c], cw[6144 + 2048 + c], cb[2048 + c], u2);
#pragma unroll
    for (int e = 0; e < 8; ++e) zreg[q2][e] = (f16)(u2[e] * u1[e]);
  }
  for (int q = tid; q < L / 2; q += 256) {
    const float4 v = reinterpret_cast<const float4*>(G)[q];
    f16x4 o = {(f16)v.x, (f16)v.y, (f16)v.z, (f16)v.w};
    *reinterpret_cast<f16x4*>(g16 + q * 4) = o;
  }
  __syncthreads();
  for (int Qp = tid; Qp < NQ; Qp += 256) {
    const int i0 = 8 * (Qp - QOFF) + L - 8;
    f16x8 lo = {0, 0, 0, 0, 0, 0, 0, 0};
    if (i0 >= 0) lo = *reinterpret_cast<const f16x8*>(g16 + i0);
    const f16x8 hi = *reinterpret_cast<const f16x8*>(g16 + i0 + 8);
    f16 wv[16];
#pragma unroll
    for (int e = 0; e < 8; ++e) { wv[e] = lo[e]; wv[8 + e] = hi[e]; }
#pragma unroll
    for (int c8 = 0; c8 < 8; ++c8) {
      f16x8 o;
#pragma unroll
      for (int jj = 0; jj < 8; ++jj) o[jj] = wv[8 + c8 - jj];
      *reinterpret_cast<f16x8*>(Gs + c8 * CS + Qp * 16) = o;
    }
  }
  __syncthreads();
#pragma unroll
  for (int q2 = 0; q2 < 2; ++q2) {
    const int u0 = (tid + 256 * q2) * 8;
    *reinterpret_cast<f16x8*>(Zs + (u0 >> 5) * 80 + (u0 & 31) * 2) = zreg[q2];
  }
  __syncthreads();
  const int r1 = r >> 3, c8 = r & 7;
  f32x16 acc, acc1, acc2, acc3;
#pragma unroll
  for (int q = 0; q < 16; ++q) { acc[q] = 0.f; acc1[q] = 0.f; acc2[q] = 0.f; acc3[q] = 0.f; }
  const char* gbase = Gs + c8 * CS + (r1 - hh + QOFF) * 16;
  const char* zbase = Zs + (b * NB) * 80 + hh * 16;
  const f16x8 zero8 = {0, 0, 0, 0, 0, 0, 0, 0};
  int d = dlo;
  for (; d + 3 <= dhi; d += 4) {
    f16x8 af[4][2], bfv[4][2];
#pragma unroll
    for (int u = 0; u < 4; ++u) {
      const int jb = i - (d + u);
      const bool valid = (unsigned)jb < (unsigned)NB;
      const int jbc = valid ? jb : 0;
#pragma unroll
      for (int s2 = 0; s2 < 2; ++s2) {
        af[u][s2] = *reinterpret_cast<const f16x8*>(gbase + (4 * (d + u) - 2 * s2) * 16);
        f16x8 t = *reinterpret_cast<const f16x8*>(zbase + jbc * 80 + s2 * 32);
        bfv[u][s2] = valid ? t : zero8;
      }
    }
    __builtin_amdgcn_sched_barrier(0);
    acc = __builtin_amdgcn_mfma_f32_32x32x16_f16(af[0][0], bfv[0][0], acc, 0, 0, 0);
    acc1 = __builtin_amdgcn_mfma_f32_32x32x16_f16(af[0][1], bfv[0][1], acc1, 0, 0, 0);
    acc2 = __builtin_amdgcn_mfma_f32_32x32x16_f16(af[1][0], bfv[1][0], acc2, 0, 0, 0);
    acc3 = __builtin_amdgcn_mfma_f32_32x32x16_f16(af[1][1], bfv[1][1], acc3, 0, 0, 0);
    acc = __builtin_amdgcn_mfma_f32_32x32x16_f16(af[2][0], bfv[2][0], acc, 0, 0, 0);
    acc1 = __builtin_amdgcn_mfma_f32_32x32x16_f16(af[2][1], bfv[2][1], acc1, 0, 0, 0);
    acc2 = __builtin_amdgcn_mfma_f32_32x32x16_f16(af[3][0], bfv[3][0], acc2, 0, 0, 0);
    acc3 = __builtin_amdgcn_mfma_f32_32x32x16_f16(af[3][1], bfv[3][1], acc3, 0, 0, 0);
    __builtin_amdgcn_sched_barrier(0);
  }
  for (; d <= dhi; ++d) {
    const int jb = i - d;
    const bool valid = (unsigned)jb < (unsigned)NB;
    const int jbc = valid ? jb : 0;
    f16x8 a0 = *reinterpret_cast<const f16x8*>(gbase + (4 * d) * 16);
    f16x8 a1 = *reinterpret_cast<const f16x8*>(gbase + (4 * d - 2) * 16);
    f16x8 b0 = *reinterpret_cast<const f16x8*>(zbase + jbc * 80);
    f16x8 b1 = *reinterpret_cast<const f16x8*>(zbase + jbc * 80 + 32);
    if (!valid) { b0 = zero8; b1 = zero8; }
    acc = __builtin_amdgcn_mfma_f32_32x32x16_f16(a0, b0, acc, 0, 0, 0);
    acc1 = __builtin_amdgcn_mfma_f32_32x32x16_f16(a1, b1, acc1, 0, 0, 0);
  }
#pragma unroll
  for (int q = 0; q < 16; ++q) acc[q] = (acc[q] + acc1[q]) + (acc2[q] + acc3[q]);
#pragma unroll
  for (int g4 = 0; g4 < 4; ++g4) {
    const int to = b * L + 32 * i + 8 * g4 + 4 * hh;
    f16x4 o;
#pragma unroll
    for (int q = 0; q < 4; ++q) o[q] = (f16)(acc[g4 * 4 + q] * (1.0f / 16.0f) * (float)mgv[g4][q]);
    *reinterpret_cast<f16x4*>(YT + to) = o;
  }
  __syncthreads();
}

template <int L>
struct HyL {
  static constexpr int NB = L / 32, QOFF = NB * 4, NQ = NB * 8, CS = NQ * 16 + 64;
};
constexpr int HC_GS_S = 0;
constexpr int HC_GS_P = 8 * HyL<2048>::CS;
constexpr int HC_ZS_S = HC_GS_P + 8 * HyL<256>::CS;
constexpr int HC_ZS_P = HC_ZS_S + 128 * 80;
constexpr int HC_MG_S = HC_ZS_P + 128 * 80;
constexpr int HC_MG_P = HC_MG_S + 128 * 80;
constexpr int HC_RED = HC_MG_P + 128 * 80;
static_assert(HC_RED + 8 * 4096 <= 2 * LDS_HALF, "hyconv LDS");

template <int L>
__device__ __forceinline__ f16x8 hc_zchunk(const f16* rx1, const f16* rv, const float* cw, const float* cb, int c, int u0, int lane,
                                          const f16x8& px1, const f16x8& pv) {
  const bool hm = (u0 & (L - 1)) != 0, hp = ((u0 + 8) & (L - 1)) != 0;
  float u1[8], u2[8];
  hy_u8s(rx1, u0, hm, hp, lane, cw[1024 + c], cw[3072 + 1024 + c], cw[6144 + 1024 + c], cb[1024 + c], u1, &px1);
  hy_u8s(rv, u0, hm, hp, lane, cw[2048 + c], cw[3072 + 2048 + c], cw[6144 + 2048 + c], cb[2048 + c], u2, &pv);
  f16x8 z;
#pragma unroll
  for (int e = 0; e < 8; ++e) z[e] = (f16)(u2[e] * u1[e]);
  return z;
}
template <int L>
__device__ __forceinline__ f16x8 hc_gchunk(const f16* rx0, const f16* rg, const float* cw, const float* cb, int c, int u0, int lane,
                                          const f16x8& px0, const f16x8& gv) {
  const bool hm = (u0 & (L - 1)) != 0, hp = ((u0 + 8) & (L - 1)) != 0;
  float u[8];
  hy_u8s(rx0, u0, hm, hp, lane, cw[c], cw[3072 + c], cw[6144 + c], cb[c], u, &px0);
  f16x8 o;
#pragma unroll
  for (int e = 0; e < 8; ++e) o[e] = (f16)(u[e] * silu_f((float)gv[e]) * (16.0f / GSCALE));
  return o;
}
template <int L>
__device__ __forceinline__ void hc_build(char* Gs, const f16* g16, int Qp) {
  constexpr int QOFF = HyL<L>::QOFF, CS = HyL<L>::CS;
  const int i0 = 8 * (Qp - QOFF) + L - 8;
  f16x8 lo = {0, 0, 0, 0, 0, 0, 0, 0};
  if (i0 >= 0) lo = *reinterpret_cast<const f16x8*>(g16 + i0);
  const f16x8 hi = *reinterpret_cast<const f16x8*>(g16 + i0 + 8);
  f16 wv[16];
#pragma unroll
  for (int e = 0; e < 8; ++e) { wv[e] = lo[e]; wv[8 + e] = hi[e]; }
#pragma unroll
  for (int c8 = 0; c8 < 8; ++c8) {
    f16x8 o;
#pragma unroll
    for (int jj = 0; jj < 8; ++jj) o[jj] = wv[8 + c8 - jj];
    *reinterpret_cast<f16x8*>(Gs + c8 * CS + Qp * 16) = o;
  }
}
template <int L>
__device__ __forceinline__ void hc_gate(const f16* rx0, const f16* rg, const float* cw, const float* cb, int c, int b, int i, int hh, f16x4 (&mgv)[4]) {
  const float w0 = cw[c], w1 = cw[3072 + c], w2 = cw[6144 + c], bb0 = cb[c];
#pragma unroll
  for (int g4 = 0; g4 < 4; ++g4) {
    const int to = b * L + 32 * i + 8 * g4 + 4 * hh;
    const f16x4 xc = *reinterpret_cast<const f16x4*>(rx0 + to);
    const f16x4 gv = *reinterpret_cast<const f16x4*>(rg + to);
    float x[6];
    x[0] = (to & (L - 1)) != 0 ? (float)rx0[to - 1] : 0.f;
    x[5] = ((to + 4) & (L - 1)) != 0 ? (float)rx0[to + 4] : 0.f;
#pragma unroll
    for (int q = 0; q < 4; ++q) x[1 + q] = (float)xc[q];
#pragma unroll
    for (int q = 0; q < 4; ++q)
      mgv[g4][q] = (f16)((bb0 + w0 * x[q] + w1 * x[q + 1] + w2 * x[q + 2]) * silu_f((float)gv[q]) * (1.0f / GSCALE) * 16.0f);
  }
}
template <int L>
__device__ __forceinline__ f32x16 hc_acc(const char* Gs, const char* Zs, int b, int i, int dlo, int dhi, int r, int hh) {
  constexpr int NB = HyL<L>::NB, QOFF = HyL<L>::QOFF, CS = HyL<L>::CS;
  const int r1 = r >> 3, c8 = r & 7;
  f32x16 acc, acc1;
#pragma unroll
  for (int q = 0; q < 16; ++q) { acc[q] = 0.f; acc1[q] = 0.f; }
  const char* gbase = Gs + c8 * CS + (r1 - hh + QOFF) * 16;
  const char* zbase = Zs + (b * NB) * 80 + hh * 16;
  const f16x8 zero8 = {0, 0, 0, 0, 0, 0, 0, 0};
  int d = dlo;
  for (; d + 3 <= dhi; d += 4) {
    f16x8 af[4][2], bfv[4][2];
#pragma unroll
    for (int u = 0; u < 4; ++u) {
      const int jb = i - (d + u);
      const bool valid = (unsigned)jb < (unsigned)NB;
      const int jbc = valid ? jb : 0;
#pragma unroll
      for (int s2 = 0; s2 < 2; ++s2) {
        af[u][s2] = *reinterpret_cast<const f16x8*>(gbase + (4 * (d + u) - 2 * s2) * 16);
        f16x8 t = *reinterpret_cast<const f16x8*>(zbase + jbc * 80 + s2 * 32);
        bfv[u][s2] = valid ? t : zero8;
      }
    }
    __builtin_amdgcn_sched_barrier(0);
    acc = __builtin_amdgcn_mfma_f32_32x32x16_f16(af[0][0], bfv[0][0], acc, 0, 0, 0);
    acc1 = __builtin_amdgcn_mfma_f32_32x32x16_f16(af[0][1], bfv[0][1], acc1, 0, 0, 0);
    acc = __builtin_amdgcn_mfma_f32_32x32x16_f16(af[1][0], bfv[1][0], acc, 0, 0, 0);
    acc1 = __builtin_amdgcn_mfma_f32_32x32x16_f16(af[1][1], bfv[1][1], acc1, 0, 0, 0);
    acc = __builtin_amdgcn_mfma_f32_32x32x16_f16(af[2][0], bfv[2][0], acc, 0, 0, 0);
    acc1 = __builtin_amdgcn_mfma_f32_32x32x16_f16(af[2][1], bfv[2][1], acc1, 0, 0, 0);
    acc = __builtin_amdgcn_mfma_f32_32x32x16_f16(af[3][0], bfv[3][0], acc, 0, 0, 0);
    acc1 = __builtin_amdgcn_mfma_f32_32x32x16_f16(af[3][1], bfv[3][1], acc1, 0, 0, 0);
    __builtin_amdgcn_sched_barrier(0);
  }
  for (; d <= dhi; ++d) {
    const int jb = i - d;
    const bool valid = (unsigned)jb < (unsigned)NB;
    const int jbc = valid ? jb : 0;
    f16x8 a0 = *reinterpret_cast<const f16x8*>(gbase + (4 * d) * 16);
    f16x8 a1 = *reinterpret_cast<const f16x8*>(gbase + (4 * d - 2) * 16);
    f16x8 b0 = *reinterpret_cast<const f16x8*>(zbase + jbc * 80);
    f16x8 b1 = *reinterpret_cast<const f16x8*>(zbase + jbc * 80 + 32);
    if (!valid) { b0 = zero8; b1 = zero8; }
    acc = __builtin_amdgcn_mfma_f32_32x32x16_f16(a0, b0, acc, 0, 0, 0);
    acc1 = __builtin_amdgcn_mfma_f32_32x32x16_f16(a1, b1, acc1, 0, 0, 0);
  }
#pragma unroll
  for (int q = 0; q < 16; ++q) acc[q] = acc[q] + acc1[q];
  return acc;
}
template <int L>
__device__ __forceinline__ void hc_epi(const f32x16& acc, const char* MGs, f16* YT, int b, int i, int hh) {
  constexpr int NB = HyL<L>::NB;
#pragma unroll
  for (int g4 = 0; g4 < 4; ++g4) {
    const int to = b * L + 32 * i + 8 * g4 + 4 * hh;
    const f16x4 mg = *reinterpret_cast<const f16x4*>(MGs + (b * NB + i) * 80 + (8 * g4 + 4 * hh) * 2);
    f16x4 o;
#pragma unroll
    for (int q = 0; q < 4; ++q) o[q] = (f16)(acc[g4 * 4 + q] * (1.0f / 16.0f) * (float)mg[q]);
    *reinterpret_cast<f16x4*>(YT + to) = o;
  }
}

__device__ __forceinline__ void phase_hyconv(const Params& p, int j, char* smem) {
  const int tid = opaque_tid512(), w = tid >> 6, lane = tid & 63, r = lane & 31, hh = lane >> 5;
  const float* cw = p.hy_conv_w + (size_t)j * 3 * 3072;
  const float* cb = p.hy_conv_b + (size_t)j * 3072;
  const f16* PT = reinterpret_cast<const f16*>(p.ws + OFF_PROJ);
  float4 fS0, fS1, fP = make_float4(0.f, 0.f, 0.f, 0.f);
  {
    const int cf = __builtin_amdgcn_readfirstlane((int)blockIdx.x);
    const float4* GS4 = reinterpret_cast<const float4*>(reinterpret_cast<const float*>(p.ws + OFF_FRAW) + ((size_t)j * 1024 + cf) * 4096);
    const float4* GP4 = reinterpret_cast<const float4*>(reinterpret_cast<const float*>(p.ws + OFF_FRAW) + (size_t)2 * 1024 * 4096 + ((size_t)j * 1024 + cf) * 512);
    fS0 = GS4[tid]; fS1 = GS4[tid + 512];
    if (tid < 128) fP = GP4[tid];
  }
  f16x8 prw[8];
#define HC_LOAD_ROWS(CC_)                                                                        \
  {                                                                                              \
    const f16* b_ = PT + (size_t)(CC_) * 8192 + tid * 8;                                         \
    _Pragma("unroll") for (int q_ = 0; q_ < 4; ++q_) {                                           \
      prw[q_] = *reinterpret_cast<const f16x8*>(b_ + (size_t)q_ * 1024 * 8192 + 4096);          \
      prw[4 + q_] = *reinterpret_cast<const f16x8*>(b_ + (size_t)q_ * 1024 * 8192);             \
    }                                                                                            \
  }
  HC_LOAD_ROWS(__builtin_amdgcn_readfirstlane((int)blockIdx.x))
  for (int c0 = blockIdx.x; c0 < 1024; c0 += gridDim.x) {
    const int c = __builtin_amdgcn_readfirstlane(c0);
    const f16* rx0 = PT + (size_t)c * 8192;
    const f16* rx1 = PT + (size_t)(1024 + c) * 8192;
    const f16* rv = PT + (size_t)(2048 + c) * 8192;
    const f16* rg = PT + (size_t)(3072 + c) * 8192;
    f16* YT = reinterpret_cast<f16*>(p.ws + OFF_YT) + (size_t)c * 8192;
    const int ct = w & 3, half = w >> 2;
    const int bS = r >> 4, iS = 16 * ct + (r & 15);
    const int dloS = half ? 16 * ct - 63 + 40 : 16 * ct - 63, dhiS = half ? 16 * ct + 15 : 16 * ct - 63 + 39;
    const int nP = ct * 32 + r, bP = nP >> 3, iP = nP & 7;
    const int dloP = half ? 1 : -7, dhiP = half ? 7 : 0;
    const f16x8 gS = hc_gchunk<2048>(rx0 + 4096, rg + 4096, cw, cb, c, tid * 8, lane, prw[0], prw[3]);
    const f16x8 gP = hc_gchunk<256>(rx0, rg, cw, cb, c, tid * 8, lane, prw[4], prw[7]);
    const f16x8 zS = hc_zchunk<2048>(rx1 + 4096, rv + 4096, cw, cb, c, tid * 8, lane, prw[1], prw[2]);
    const f16x8 zP = hc_zchunk<256>(rx1, rv, cw, cb, c, tid * 8, lane, prw[5], prw[6]);
    f16* g16S = reinterpret_cast<f16*>(smem + HC_ZS_S);
    f16* g16P = reinterpret_cast<f16*>(smem + HC_ZS_P);
    *reinterpret_cast<f16x4*>(g16S + tid * 4) = f16x4{(f16)fS0.x, (f16)fS0.y, (f16)fS0.z, (f16)fS0.w};
    *reinterpret_cast<f16x4*>(g16S + (tid + 512) * 4) = f16x4{(f16)fS1.x, (f16)fS1.y, (f16)fS1.z, (f16)fS1.w};
    if (tid < 128) *reinterpret_cast<f16x4*>(g16P + tid * 4) = f16x4{(f16)fP.x, (f16)fP.y, (f16)fP.z, (f16)fP.w};
    __syncthreads();
    hc_build<2048>(smem + HC_GS_S, g16S, tid);
    if (tid >= 448) hc_build<256>(smem + HC_GS_P, g16P, tid - 448);
    __syncthreads();
    {
      const int u0 = tid * 8;
      *reinterpret_cast<f16x8*>(smem + HC_ZS_S + (u0 >> 5) * 80 + (u0 & 31) * 2) = zS;
      *reinterpret_cast<f16x8*>(smem + HC_ZS_P + (u0 >> 5) * 80 + (u0 & 31) * 2) = zP;
      *reinterpret_cast<f16x8*>(smem + HC_MG_S + (u0 >> 5) * 80 + (u0 & 31) * 2) = gS;
      *reinterpret_cast<f16x8*>(smem + HC_MG_P + (u0 >> 5) * 80 + (u0 & 31) * 2) = gP;
    }
    __syncthreads();
    if (c0 + (int)gridDim.x < 1024) {
      const int cf = __builtin_amdgcn_readfirstlane(c0 + (int)gridDim.x);
      const float4* GS4 = reinterpret_cast<const float4*>(reinterpret_cast<const float*>(p.ws + OFF_FRAW) + ((size_t)j * 1024 + cf) * 4096);
      const float4* GP4 = reinterpret_cast<const float4*>(reinterpret_cast<const float*>(p.ws + OFF_FRAW) + (size_t)2 * 1024 * 4096 + ((size_t)j * 1024 + cf) * 512);
      fS0 = GS4[tid]; fS1 = GS4[tid + 512];
      if (tid < 128) fP = GP4[tid];
      HC_LOAD_ROWS(cf)
    }
    f32x16 accS = hc_acc<2048>(smem + HC_GS_S, smem + HC_ZS_S, bS, iS, dloS, dhiS, r, hh);
    f32x16 accP = hc_acc<256>(smem + HC_GS_P, smem + HC_ZS_P, bP, iP, dloP, dhiP, r, hh);
    float* redS = reinterpret_cast<float*>(smem + HC_RED + (ct * 2 + 0) * 4096) + lane * 16;
    float* redP = reinterpret_cast<float*>(smem + HC_RED + (ct * 2 + 1) * 4096) + lane * 16;
    if (half) {
#pragma unroll
      for (int q = 0; q < 4; ++q) {
        *reinterpret_cast<f32x4*>(redS + 4 * q) = f32x4{accS[4 * q], accS[4 * q + 1], accS[4 * q + 2], accS[4 * q + 3]};
        *reinterpret_cast<f32x4*>(redP + 4 * q) = f32x4{accP[4 * q], accP[4 * q + 1], accP[4 * q + 2], accP[4 * q + 3]};
      }
    }
    __syncthreads();
    if (!half) {
#pragma unroll
      for (int q = 0; q < 4; ++q) {
        const f32x4 a = *reinterpret_cast<const f32x4*>(redS + 4 * q), bq = *reinterpret_cast<const f32x4*>(redP + 4 * q);
#pragma unroll
        for (int e = 0; e < 4; ++e) { accS[4 * q + e] += a[e]; accP[4 * q + e] += bq[e]; }
      }
      hc_epi<2048>(accS, smem + HC_MG_S, YT + 4096, bS, iS, hh);
      hc_epi<256>(accP, smem + HC_MG_P, YT, bP, iP, hh);
    }
    __syncthreads();
  }
}

__device__ __forceinline__ void phase_hygate(const Params& p, char* smem) {
  f16(*yt)[72] = reinterpret_cast<f16(*)[72]>(smem);
  const int tid = opaque_tid();
  const f16* YT = reinterpret_cast<const f16*>(p.ws + OFF_YT);
  const f16* MG = reinterpret_cast<const f16*>(p.ws + OFF_MG);
  f16* A2 = reinterpret_cast<f16*>(p.ws + OFF_A2);
  for (int t = VBID; t < 2048; t += VGRID) {
    const int tok0 = (t & 127) * 64, c0 = (t >> 7) * 64;
    {
      const int cc = tid >> 2, seg = tid & 3;
      const f16* s = YT + (size_t)(c0 + cc) * 8192 + tok0 + seg * 16;
      *reinterpret_cast<f16x8*>(&yt[cc][seg * 16]) = *reinterpret_cast<const f16x8*>(s);
      *reinterpret_cast<f16x8*>(&yt[cc][seg * 16 + 8]) = *reinterpret_cast<const f16x8*>(s + 8);
    }
    __syncthreads();
    const int cgp = tid & 7, tr = tid >> 3;
#pragma unroll
    for (int rr = 0; rr < 2; ++rr) {
      const int trow = tr + rr * 32, tok = tok0 + trow;
      f16x8 mg = *reinterpret_cast<const f16x8*>(MG + (size_t)tok * 1024 + c0 + cgp * 8);
      f16x8 o;
#pragma unroll
      for (int e = 0; e < 8; ++e) o[e] = (f16)((float)yt[cgp * 8 + e][trow] * (float)mg[e]);
      *reinterpret_cast<f16x8*>(A2 + (size_t)tok * 1024 + c0 + cgp * 8) = o;
    }
    __syncthreads();
  }
}

__device__ __forceinline__ void phase_mlaprep(const Params& p, int j, int mode) {
  const int tid = opaque_tid(), w = tid >> 6, lane = tid & 63;
  const f16* PROJ = reinterpret_cast<const f16*>(p.ws + OFF_PROJ);
  f16* QN = reinterpret_cast<f16*>(p.ws + M_QN);
  f16* CKV = reinterpret_cast<f16*>(p.ws + M_CKV);
  f16* KPEP = reinterpret_cast<f16*>(p.ws + M_KPEP);
  f16* KPES = reinterpret_cast<f16*>(p.ws + M_KPES);
  float* st_ckv = p.out + 2 * 4194304;
  float* st_kpe = st_ckv + 2097152;
  const f16x8 zero8 = {0, 0, 0, 0, 0, 0, 0, 0};
  const int tlo = mode == 0 ? 2048 : 0, thi = mode == 0 ? NKV / 4 : 2048;
  for (int t = tlo + VBID; t < thi; t += VGRID) {
    const int row = t * 4 + w;
    if (row < 8192) {
      const f16* pr = PROJ + (size_t)row * MLA_IN;
      const f16x8 c0 = *reinterpret_cast<const f16x8*>(pr + lane * 8);
      f16x8 c1 = zero8;
      if (lane < 20) c1 = *reinterpret_cast<const f16x8*>(pr + 512 + lane * 8);
      float f0[8], f1[8], s0 = 0.f, s1 = 0.f;
#pragma unroll
      for (int e = 0; e < 8; ++e) { f0[e] = (float)c0[e]; f1[e] = (float)c1[e]; s0 += f0[e] * f0[e]; s1 += f1[e] * f1[e]; }
      const float ssq = wave_sum(lane < 48 ? s0 : 0.f);
      const float sskv = wave_sum((lane >= 48 ? s0 : 0.f) + (lane < 16 ? s1 : 0.f));
      const float rq = rsqrtf(ssq * (1.f / 384.f) + 1e-6f), rkv = rsqrtf(sskv * (1.f / 256.f) + 1e-6f);
      const bool prompt = row < 4096;
      const int b = prompt ? row >> 8 : (row - 4096) >> 11, tq = prompt ? row & 255 : (row - 4096) & 2047;
      if (lane < 48) {
        const float4 g0 = *reinterpret_cast<const float4*>(p.mla_q_norm + j * 384 + lane * 8);
        const float4 g1 = *reinterpret_cast<const float4*>(p.mla_q_norm + j * 384 + lane * 8 + 4);
        f16x8 o;
        o[0] = (f16)(f0[0] * rq * g0.x); o[1] = (f16)(f0[1] * rq * g0.y); o[2] = (f16)(f0[2] * rq * g0.z); o[3] = (f16)(f0[3] * rq * g0.w);
        o[4] = (f16)(f0[4] * rq * g1.x); o[5] = (f16)(f0[5] * rq * g1.y); o[6] = (f16)(f0[6] * rq * g1.z); o[7] = (f16)(f0[7] * rq * g1.w);
        (void)o; (void)QN;
      }
      if (lane >= 48 || lane < 16) {
        const int kc = lane >= 48 ? (lane - 48) * 8 : (16 + lane) * 8;
        const float4 g0 = *reinterpret_cast<const float4*>(p.mla_kv_norm + j * 256 + kc);
        const float4 g1 = *reinterpret_cast<const float4*>(p.mla_kv_norm + j * 256 + kc + 4);
        float v[8];
#pragma unroll
        for (int e = 0; e < 8; ++e) v[e] = (lane >= 48 ? f0[e] : f1[e]) * rkv;
        v[0] *= g0.x; v[1] *= g0.y; v[2] *= g0.z; v[3] *= g0.w; v[4] *= g1.x; v[5] *= g1.y; v[6] *= g1.z; v[7] *= g1.w;
        f16x8 o;
#pragma unroll
        for (int e = 0; e < 8; ++e) o[e] = (f16)v[e];
        (void)o;
        if (prompt) {
          float* d = st_ckv + (((size_t)b * 2 + j) * 256 + tq) * 256 + kc;
#pragma unroll
          for (int e = 0; e < 8; ++e) __builtin_nontemporal_store(v[e], d + e);
        }
      }
      float oth[8];
#pragma unroll
      for (int e = 0; e < 8; ++e) oth[e] = __shfl_xor(f1[e], 1);
      if (lane >= 16 && lane < 20) {
        const int q = lane - 16;
        if (prompt) {
          f16x8 o;
#pragma unroll
          for (int e = 0; e < 8; ++e) o[e] = (f16)f1[e];
          *reinterpret_cast<f16x8*>(KPEP + (size_t)row * 32 + q * 8) = o;
          float* d = st_kpe + (((size_t)b * 2 + j) * 256 + tq) * 32 + q * 8;
          *reinterpret_cast<float4*>(d) = make_float4(f1[0], f1[1], f1[2], f1[3]);
          *reinterpret_cast<float4*>(d + 4) = make_float4(f1[4], f1[5], f1[6], f1[7]);
        } else {
          const float pos = (q >> 1) == 0 ? (float)(tq >> 6) : (float)(tq & 63);
          f16x8 o;
#pragma unroll
          for (int e = 0; e < 8; ++e) {
            const float inv = exp2f(-(float)(2 * e) * (13.287712379549449f / 16.f));
            const float ang = pos * inv;
            const float cs = cosf(ang), sn = sinf(ang);
            o[e] = (f16)((q & 1) == 0 ? f1[e] * cs - oth[e] * sn : f1[e] * cs + oth[e] * sn);
          }
          *reinterpret_cast<f16x8*>(KPES + ((size_t)b * 2560 + tq) * 32 + q * 8) = o;
        }
      }
    } else {
      const int cr = row - 8192, b = cr >> 9, key = cr & 511;
      const float* src = p.cache_ckv + (((size_t)b * 2 + j) * 512 + key) * 256;
      const float4 v = *reinterpret_cast<const float4*>(src + lane * 4);
      f16x4 o = {(f16)v.x, (f16)v.y, (f16)v.z, (f16)v.w};
      *reinterpret_cast<f16x4*>(CKV + (size_t)row * 256 + lane * 4) = o;
      if (lane < 32)
        KPES[((size_t)b * 2560 + 2048 + key) * 32 + lane] = (f16)p.cache_kpe[(((size_t)b * 2 + j) * 512 + key) * 32 + lane];
    }
  }
}

__device__ __forceinline__ void phase_attn(const Params& p, char* smem) {
  const int tid = opaque_tid512(), w = tid >> 6, lane = tid & 63, r = lane & 31, hh = lane >> 5;
  constexpr int ATT_BUF = 64 * 208 + 64 * 144;
  const f16* Q = reinterpret_cast<const f16*>(p.ws + M_Q);
  const f16* PROJ = reinterpret_cast<const f16*>(p.ws + OFF_PROJ);
  f16* A2 = reinterpret_cast<f16*>(p.ws + OFF_A2);
  const int G = gridDim.x;
  for (int t0 = blockIdx.x; t0 < 512; t0 += G) {
    int t = t0;
    if (G == 256) {
      const int v = t0 & 255, x = v & 7, li = v >> 3;
      t = (t0 & 256) + x * 32 + li;
    }
    const bool sample = t < 256;
    int bh, qc, Lk;
    if (sample) { bh = t >> 3; qc = t & 7; Lk = 2560; } else { bh = t - 256; qc = 0; Lk = 256; }
    const int b = bh >> 4, h = bh & 15;
    const int tq = qc * 256 + w * 32 + r;
    const int tok = sample ? 4096 + b * 2048 + tq : b * 256 + tq;
    const f16* KN = reinterpret_cast<const f16*>(p.ws + (sample ? M_KNS : M_KNP)) + (size_t)bh * Lk * 64;
    const f16* VT = reinterpret_cast<const f16*>(p.ws + (sample ? M_VTS : M_VTP)) + (size_t)bh * 64 * Lk;
    const f16* KPE = reinterpret_cast<const f16*>(p.ws + (sample ? M_KPES : M_KPEP)) + (size_t)b * Lk * 32;
    f16x8 qf[6];
    const f16* qp = Q + (size_t)tok * 1536 + h * 96;
#pragma unroll
    for (int ks = 0; ks < 4; ++ks) qf[ks] = *reinterpret_cast<const f16x8*>(qp + ks * 16 + hh * 8);
    if (!sample) {
      qf[4] = *reinterpret_cast<const f16x8*>(qp + 64 + hh * 8);
      qf[5] = *reinterpret_cast<const f16x8*>(qp + 80 + hh * 8);
    } else {
#pragma unroll
      for (int g = 0; g < 2; ++g) {
        const f16x8 x1 = *reinterpret_cast<const f16x8*>(qp + 64 + g * 16);
        const f16x8 x2 = *reinterpret_cast<const f16x8*>(qp + 64 + g * 16 + 8);
        const float pos = g == 0 ? (float)(tq >> 6) : (float)(tq & 63);
#pragma unroll
        for (int i = 0; i < 8; ++i) {
          const float inv = exp2f(-(float)(2 * i) * (13.287712379549449f / 16.f));
          const float ang = pos * inv;
          const float cs = cosf(ang), sn = sinf(ang);
          const float a1 = (float)x1[i], a2 = (float)x2[i];
          qf[4 + g][i] = (f16)(hh == 0 ? a1 * cs - a2 * sn : a2 * cs + a1 * sn);
        }
      }
    }
    f32x16 O0, O1;
#pragma unroll
    for (int q = 0; q < 16; ++q) { O0[q] = 0.f; O1[q] = 0.f; }
    float m = -1e30f;
    f32x2 lacc = {0.f, 0.f};
    const int nkt = Lk >> 6;
    f16x8 pk0, pkpe, pv0;
    const f16* kn_t = KN + (size_t)(tid >> 3) * 64 + (tid & 7) * 8;
    const f16* kpe_t = KPE + (size_t)((tid & 255) >> 2) * 32 + (tid & 3) * 8;
    const f16* vt_t = VT + (size_t)(tid >> 3) * Lk + (tid & 7) * 8;
    const int kw0 = (tid >> 3) * 208 + (tid & 7) * 16, kwp = ((tid & 255) >> 2) * 208 + 128 + (tid & 3) * 16;
    const int vw0 = (tid >> 3) * 144 + ((tid & 7) >> 1) * 32 + ((tid & 7) & 1) * 8;
    const bool lowhalf = tid < 256;
#define ATT_LOAD(KT_)                                                                      \
  {                                                                                        \
    const int key0_ = (KT_) * 64;                                                          \
    pk0 = *reinterpret_cast<const f16x8*>(kn_t + (size_t)key0_ * 64);                      \
    if (lowhalf) pkpe = *reinterpret_cast<const f16x8*>(kpe_t + (size_t)key0_ * 32);       \
    pv0 = *reinterpret_cast<const f16x8*>(vt_t + key0_);                                   \
  }
#define ATT_STORE(BUF_)                                                                    \
  {                                                                                        \
    char* kb_ = smem + (BUF_) * ATT_BUF;                                                   \
    char* vb_ = kb_ + 64 * 208;                                                            \
    *reinterpret_cast<f16x8*>(kb_ + kw0) = pk0;                                            \
    if (lowhalf) *reinterpret_cast<f16x8*>(kb_ + kwp) = pkpe;                              \
    *reinterpret_cast<f16x4*>(vb_ + vw0) = f16x4{pv0[0], pv0[1], pv0[2], pv0[3]};          \
    *reinterpret_cast<f16x4*>(vb_ + vw0 + 16) = f16x4{pv0[4], pv0[5], pv0[6], pv0[7]};     \
  }
    const bool rot = tid >= 256;
    f32x16 s0, s1;
#define ATT_QK(BUFI_)                                                                               \
  {                                                                                                 \
    const char* KS_ = smem + (BUFI_) * ATT_BUF;                                                     \
    f16x8 ka0[6], ka1[6];                                                                           \
    _Pragma("unroll") for (int ks = 0; ks < 6; ++ks) {                                              \
      ka0[ks] = *reinterpret_cast<const f16x8*>(KS_ + r * 208 + ks * 32 + hh * 16);                 \
      ka1[ks] = *reinterpret_cast<const f16x8*>(KS_ + (32 + r) * 208 + ks * 32 + hh * 16);          \
    }                                                                                               \
    _Pragma("unroll") for (int q = 0; q < 16; ++q) { s0[q] = 0.f; s1[q] = 0.f; }                    \
    __builtin_amdgcn_sched_barrier(0);                                                              \
    _Pragma("unroll") for (int ks = 0; ks < 6; ++ks) {                                              \
      s0 = __builtin_amdgcn_mfma_f32_32x32x16_f16(ka0[ks], qf[ks], s0, 0, 0, 0);                    \
      s1 = __builtin_amdgcn_mfma_f32_32x32x16_f16(ka1[ks], qf[ks], s1, 0, 0, 0);                    \
    }                                                                                               \
  }
    {
      f16x8 qk0, qkpe, qv0;
      pk0 = *reinterpret_cast<const f16x8*>(kn_t);
      if (lowhalf) pkpe = *reinterpret_cast<const f16x8*>(kpe_t);
      pv0 = *reinterpret_cast<const f16x8*>(vt_t);
      qk0 = *reinterpret_cast<const f16x8*>(kn_t + (size_t)64 * 64);
      if (lowhalf) qkpe = *reinterpret_cast<const f16x8*>(kpe_t + (size_t)64 * 32);
      qv0 = *reinterpret_cast<const f16x8*>(vt_t + 64);
      ATT_STORE(0)
      pk0 = qk0; pv0 = qv0;
      if (lowhalf) pkpe = qkpe;
      ATT_STORE(1)
    }
    if (nkt > 2) ATT_LOAD(2)
    __syncthreads();
    ATT_QK(0)
    int bcur = 0;
    for (int kt = 0; kt < nkt; ++kt) {
      const int bnext = bcur == 2 ? 0 : bcur + 1, bnext2 = bnext == 2 ? 0 : bnext + 1;
      if (!rot) __syncthreads();
      const char* VS = smem + bcur * ATT_BUF + 64 * 208;
      float mx;
      {
        float t0, t1, t2, t3;
        asm volatile("s_nop 15\n\ts_nop 7");
        asm("v_max3_f32 %0, %1, %2, %3" : "=v"(t0) : "v"(s0[0]), "v"(s0[1]), "v"(s0[2]));
        asm("v_max3_f32 %0, %1, %2, %3" : "=v"(t1) : "v"(s0[3]), "v"(s0[4]), "v"(s0[5]));
        asm("v_max3_f32 %0, %1, %2, %3" : "=v"(t2) : "v"(s0[6]), "v"(s0[7]), "v"(s0[8]));
        asm("v_max3_f32 %0, %1, %2, %3" : "=v"(t3) : "v"(s0[9]), "v"(s0[10]), "v"(s0[11]));
        asm("v_max3_f32 %0, %1, %2, %3" : "=v"(t0) : "v"(t0), "v"(s0[12]), "v"(s0[13]));
        asm("v_max3_f32 %0, %1, %2, %3" : "=v"(t1) : "v"(t1), "v"(s0[14]), "v"(s0[15]));
        asm("v_max3_f32 %0, %1, %2, %3" : "=v"(t2) : "v"(t2), "v"(s1[0]), "v"(s1[1]));
        asm("v_max3_f32 %0, %1, %2, %3" : "=v"(t3) : "v"(t3), "v"(s1[2]), "v"(s1[3]));
        asm("v_max3_f32 %0, %1, %2, %3" : "=v"(t0) : "v"(t0), "v"(s1[4]), "v"(s1[5]));
        asm("v_max3_f32 %0, %1, %2, %3" : "=v"(t1) : "v"(t1), "v"(s1[6]), "v"(s1[7]));
        asm("v_max3_f32 %0, %1, %2, %3" : "=v"(t2) : "v"(t2), "v"(s1[8]), "v"(s1[9]));
        asm("v_max3_f32 %0, %1, %2, %3" : "=v"(t3) : "v"(t3), "v"(s1[10]), "v"(s1[11]));
        asm("v_max3_f32 %0, %1, %2, %3" : "=v"(t0) : "v"(t0), "v"(s1[12]), "v"(s1[13]));
        asm("v_max3_f32 %0, %1, %2, %3" : "=v"(t1) : "v"(t1), "v"(s1[14]), "v"(s1[15]));
        asm("v_max3_f32 %0, %1, %2, %3" : "=v"(t0) : "v"(t0), "v"(t1), "v"(t2));
        asm("v_max_f32 %0, %1, %2" : "=v"(mx) : "v"(t0), "v"(t3));
      }
      mx = fmaxf(mx, __shfl_xor(mx, 32));
      if (__builtin_amdgcn_ballot_w64(mx > m + 8.f) != 0ull) {
        const float mn = fmaxf(m, mx);
        const float alpha = __builtin_amdgcn_exp2f(m - mn);
        m = mn;
        lacc *= alpha;
        O0 *= alpha;
        O1 *= alpha;
      }
      const f32x2 mm = {m, m};
      f16x8 pf[4];
#pragma unroll
      for (int s2 = 0; s2 < 2; ++s2)
#pragma unroll
        for (int jj = 0; jj < 8; jj += 2) {
          const f32x2 d0 = f32x2{s0[8 * s2 + jj], s0[8 * s2 + jj + 1]} - mm;
          const f32x2 d1 = f32x2{s1[8 * s2 + jj], s1[8 * s2 + jj + 1]} - mm;
          const f32x2 e0 = {__builtin_amdgcn_exp2f(d0[0]), __builtin_amdgcn_exp2f(d0[1])};
          const f32x2 e1 = {__builtin_amdgcn_exp2f(d1[0]), __builtin_amdgcn_exp2f(d1[1])};
          lacc += e0;
          lacc += e1;
          pf[s2][jj] = (f16)e0[0]; pf[s2][jj + 1] = (f16)e0[1];
          pf[2 + s2][jj] = (f16)e1[0]; pf[2 + s2][jj + 1] = (f16)e1[1];
        }
      f16x8 vfa[4], vfb[4];
#pragma unroll
      for (int us = 0; us < 4; ++us) {
        const char* vp0 = VS + r * 144 + ((us >> 1) * 32 + 16 * (us & 1) + 8 * hh) * 2;
        vfa[us] = *reinterpret_cast<const f16x8*>(vp0);
        vfb[us] = *reinterpret_cast<const f16x8*>(vp0 + 32 * 144);
      }
#pragma unroll
      for (int us = 0; us < 4; ++us) {
        O0 = __builtin_amdgcn_mfma_f32_32x32x16_f16(vfa[us], pf[us], O0, 0, 0, 0);
        O1 = __builtin_amdgcn_mfma_f32_32x32x16_f16(vfb[us], pf[us], O1, 0, 0, 0);
      }
      if (rot) __syncthreads();
      if (kt + 1 < nkt) ATT_QK(bnext)
      if (kt + 2 < nkt) ATT_STORE(bnext2)
      if (kt + 3 < nkt) ATT_LOAD(kt + 3)
      bcur = bnext;
    }
    __syncthreads();
#undef ATT_QK
#undef ATT_LOAD
#undef ATT_STORE
    float l = lacc[0] + lacc[1];
    l += __shfl_xor(l, 32);
    const float il = 1.f / l;
#pragma unroll
    for (int dt = 0; dt < 2; ++dt)
#pragma unroll
      for (int g4 = 0; g4 < 4; ++g4) {
        const int dv0 = 32 * dt + 8 * g4 + 4 * hh;
        const f16x4 gt = *reinterpret_cast<const f16x4*>(PROJ + (size_t)tok * MLA_IN + 672 + h * 64 + dv0);
        f16x4 o;
#pragma unroll
        for (int q = 0; q < 4; ++q) {
          const float ov = dt == 0 ? O0[g4 * 4 + q] : O1[g4 * 4 + q];
          o[q] = (f16)(ov * il * silu_f((float)gt[q]));
        }
        *reinterpret_cast<f16x4*>(A2 + (size_t)tok * 1024 + h * 64 + dv0) = o;
      }
  }
}

__device__ __forceinline__ void phase_final(const Params& p) {
  const int tid = opaque_tid(), w = tid >> 6, lane = tid & 63;
  const float4* X = reinterpret_cast<const float4*>(p.ws + OFF_X);
  const float4* nw = reinterpret_cast<const float4*>(p.final_norm);
  float4* O = reinterpret_cast<float4*>(p.out);
  for (int t = VBID; t < 2048; t += VGRID) {
    const int row = t * 4 + w;
    float4 v[4];
    float ss = 0.f;
#pragma unroll
    for (int i = 0; i < 4; ++i) {
      v[i] = X[(size_t)row * 256 + lane + 64 * i];
      ss += v[i].x * v[i].x + v[i].y * v[i].y + v[i].z * v[i].z + v[i].w * v[i].w;
    }
    ss = wave_sum(ss);
    const float rstd = rsqrtf(ss * (1.f / 1024.f) + 1e-6f);
#pragma unroll
    for (int i = 0; i < 4; ++i) {
      const int q = lane + 64 * i;
      float4 g = nw[q];
      float* op_ = reinterpret_cast<float*>(O + (size_t)row * 256 + q);
      __builtin_nontemporal_store(v[i].x * rstd * g.x, op_); __builtin_nontemporal_store(v[i].y * rstd * g.y, op_ + 1);
      __builtin_nontemporal_store(v[i].z * rstd * g.z, op_ + 2); __builtin_nontemporal_store(v[i].w * rstd * g.w, op_ + 3);
    }
  }
}

#define XB_TMO      128
#define XB_XCNT(j)  (256  + 64 * (j))
#define XB_XSUB(j)  (1280 + 64 * (j))
#define XB_XGEN(j)  (2304 + 64 * (j))
#define XB_TOP      3328
#define XB_TOPGEN   3392
#define XCD_BAR_WORDS 3456
#define XB_SPIN_CAP (1u << 22)
#define LAS __attribute__((address_space(3)))
__device__ __forceinline__ unsigned xb_ld(unsigned* p) { return __hip_atomic_load(p, __ATOMIC_RELAXED, __HIP_MEMORY_SCOPE_AGENT); }
__device__ __forceinline__ unsigned xb_add(unsigned* p, unsigned v) { return __hip_atomic_fetch_add(p, v, __ATOMIC_RELAXED, __HIP_MEMORY_SCOPE_AGENT); }
__device__ __forceinline__ unsigned xb_xcc_id() { return (unsigned)__builtin_amdgcn_s_getreg((3 << 11) | 20) & 0xFu; }
#define XB_SPIN(cond, bar) do { unsigned _sp = 0; while (cond) { __builtin_amdgcn_s_sleep(1); \
    if ((++_sp & 255u) == 0u) { if (xb_ld(&(bar)[XB_TMO])) break; if (_sp > XB_SPIN_CAP) { atomicAdd(&(bar)[XB_TMO], 1u); break; } } } } while (0)
struct XcdBarrier { unsigned* bar; unsigned x; volatile LAS unsigned* st; };
__device__ __forceinline__ XcdBarrier xcd_barrier_post(unsigned* bar, volatile LAS unsigned* st) {
  XcdBarrier b; b.bar = bar; b.x = xb_xcc_id(); b.st = st;
  if (threadIdx.x == 0) (void)xb_add(&bar[XB_XCNT(b.x)], 1u);
  return b;
}
__device__ __forceinline__ void xcd_barrier_complete(unsigned* bar, unsigned x, unsigned& nloc, unsigned& nx) {
  const unsigned G = gridDim.x * gridDim.y * gridDim.z;
  unsigned sum, cnt, mine, sp = 0u;
  for (;;) {
    sum = 0u; cnt = 0u; mine = 0u;
#pragma unroll
    for (unsigned j = 0; j < 16; ++j) { const unsigned c = xb_ld(&bar[XB_XCNT(j)]); sum += c; cnt += (c > 0u) ? 1u : 0u; mine = (j == x) ? c : mine; }
    if (sum == G) break;
    __builtin_amdgcn_s_sleep(1);
    if ((++sp & 255u) == 0u) { if (xb_ld(&bar[XB_TMO])) break; if (sp > XB_SPIN_CAP) { atomicAdd(&bar[XB_TMO], 1u); break; } }
  }
  nloc = mine > 0u ? mine : 1u; nx = cnt > 0u ? cnt : 1u;
}
__device__ __forceinline__ void xcd_barrier(const XcdBarrier& b) {
  asm volatile("s_waitcnt vmcnt(0)" ::: "memory");
  __syncthreads();
  if (threadIdx.x == 0) {
    unsigned* bar = b.bar;
    __builtin_amdgcn_s_waitcnt(0);
    unsigned nloc = b.st[0], nx = b.st[1];
    if (nloc == 0u) { xcd_barrier_complete(bar, b.x, nloc, nx); b.st[0] = nloc; b.st[1] = nx; }
    const unsigned old = xb_add(&bar[XB_XSUB(b.x)], 1u);
    const unsigned gen = old / nloc;
    if (old + 1u == (gen + 1u) * nloc) {
      __builtin_amdgcn_fence(__ATOMIC_RELEASE, "agent");
      asm volatile("s_waitcnt vmcnt(0)" ::: "memory");
      const unsigned og = xb_add(&bar[XB_TOP], 1u);
      const unsigned tg = og / nx;
      if (og + 1u == (tg + 1u) * nx) xb_add(&bar[XB_TOPGEN], 1u);
      else XB_SPIN(xb_ld(&bar[XB_TOPGEN]) == tg, bar);
      __builtin_amdgcn_fence(__ATOMIC_ACQUIRE, "agent");
      xb_add(&bar[XB_XGEN(b.x)], 1u);
      asm volatile("s_waitcnt vmcnt(0)" ::: "memory");
    } else {
      XB_SPIN(xb_ld(&bar[XB_XGEN(b.x)]) == gen, bar);
      __builtin_amdgcn_fence(__ATOMIC_ACQUIRE, "agent");
      asm volatile("s_waitcnt vmcnt(0)" ::: "memory");
    }
  }
  __syncthreads();
}

#ifndef REP_ATTN
#define REP_ATTN 1
#endif
#ifndef REP_G1
#define REP_G1 1
#endif
#ifndef REP_BAR
#define REP_BAR 1
#endif
#ifndef REP_P0
#define REP_P0 1
#endif
#ifndef REP_EW
#define REP_EW 1
#endif
#ifndef REP_G2
#define REP_G2 1
#endif
#ifndef REP_P1
#define REP_P1 1
#endif
#ifndef REP_OUT
#define REP_OUT 1
#endif
#ifndef REP_CONV
#define REP_CONV 1
#endif
#define GSYNC() do { for (int _b = 0; _b < opaque_int(REP_BAR); ++_b) xcd_barrier(xb); } while (0)

__global__ void __launch_bounds__(512, 2) fwd_megakernel(Params p) {
  cg::grid_group grid = cg::this_grid();
  extern __shared__ __attribute__((aligned(16))) char smem_all[];
#define smem (smem_all + (opaque_tid512() >> 8) * LDS_HALF)
  __shared__ uint4 xb_words;
  if (threadIdx.x == 0) xb_words = make_uint4(0u, 0u, 0u, 0u);
  __syncthreads();
  if (p.ws == nullptr) grid.sync();
  XcdBarrier xb = xcd_barrier_post(reinterpret_cast<unsigned*>(p.ws + OFF_BAR), (volatile LAS unsigned*)&xb_words);
  const float* MOD = reinterpret_cast<const float*>(p.ws + OFF_MOD);
  float* X = reinterpret_cast<float*>(p.ws + OFF_X);
  const f16* H = reinterpret_cast<const f16*>(p.ws + OFF_H);
  f16* PROJ = reinterpret_cast<f16*>(p.ws + OFF_PROJ);
  const f16* A2 = reinterpret_cast<const f16*>(p.ws + OFF_A2);

  for (int _r = 0; _r < opaque_int(REP_P0); ++_r) phase0(p, smem);
  GSYNC();
  for (int layer = 0; layer < 4; ++layer) {
    const int j = layer >> 1;
    for (int _r = 0; _r < opaque_int(REP_EW); ++_r) phase_norm(p, layer);
    if (layer == 0) {
      for (int _r = 0; _r < opaque_int(REP_P1); ++_r) phase1(p, smem);
      for (int t = VBID; t < 288; t += VGRID) ada_tile(p, 96 + t, smem);
    }
    GSYNC();
    if ((layer & 1) == 0) {
      {
        const f16* W = reinterpret_cast<const f16*>(p.ws + OFF_WHIN) + (size_t)j * 4096 * 1024;
        if (layer == 0) phase_filter_norm(p);
        EpiStoreT epi{PROJ, 8192};
        for (int _r = 0; _r < opaque_int(REP_G1); ++_r) gemm512<0, 4, 0, 1, 0>(H, 1024, W, 1024, 1024, 32, 32 * 16, blockIdx.x, gridDim.x, smem_all, epi);
      }
      GSYNC();
      for (int _r = 0; _r < opaque_int(REP_CONV); ++_r) phase_hyconv(p, j, smem_all);
      GSYNC();
      {
        const f16* A2T = reinterpret_cast<const f16*>(p.ws + OFF_YT);
        const f16* W = reinterpret_cast<const f16*>(p.ws + OFF_WHOUT) + (size_t)j * 1024 * 1024;
        EpiResid epi{X, MOD + layer * 3 * 3072, layer == 0 ? p.x_prompt : X, layer == 0 ? p.x_sample : X + (size_t)4096 * 1024};
        gemm512<1, 2, 1, 0, 0>(A2T, 8192, W, 1024, 1024, 32, 32 * 8, blockIdx.x, gridDim.x, smem_all, epi);
        for (int _r = 1; _r < opaque_int(REP_OUT); ++_r) gemm512<1, 2, 1, 0, 0>(A2T, 8192, W, 1024, 1024, 32, 32 * 8, blockIdx.x, gridDim.x, smem_all, EpiNull{});
      }
      GSYNC();
    } else {
      {
        const f16* W = reinterpret_cast<const f16*>(p.ws + OFF_WMIN) + (size_t)j * MLA_INP * 1024;
        phase_mlaprep(p, j, 0);
        EpiStoreF16 epi{PROJ, MLA_IN, MLA_IN, 1.f};
        for (int _r = 0; _r < opaque_int(REP_G2); ++_r) gemm512<1, 4, 0, 0, 0>(H, 1024, W, 1024, 1024, 32, 32 * 7, blockIdx.x, gridDim.x, smem_all, epi);
      }
      GSYNC();
      {
        const f16* WQ = reinterpret_cast<const f16*>(p.ws + OFF_WQB) + (size_t)j * 1536 * 384;
        const f16* WKV = reinterpret_cast<const f16*>(p.ws + OFF_WKVB) + (size_t)j * 2048 * 256;
        const f16* CKVC = reinterpret_cast<const f16*>(p.ws + M_CKV) + (size_t)8192 * 256;
        const float qscale = 0.10206207261596577f * 1.4426950408889634f;
        const float* rstdS = reinterpret_cast<const float*>(smem_all + 2 * 65536);
        EpiStoreF16 eq{reinterpret_cast<f16*>(p.ws + M_Q), 1536, 1536, qscale, rstdS};
        EpiKV ekv{p.ws, rstdS};
        for (int _r = 0; _r < opaque_int(REP_G2); ++_r) {
        gemm512<0, 4, 0, 0, 1>(PROJ + 384, MLA_IN, WKV, 256, 256, 36, 36 * 8, blockIdx.x, gridDim.x, smem_all, ekv, CKVC, 256, 32);
        gemm512<1, 4, 0, 0, 1>(PROJ, MLA_IN, WQ, 384, 384, 32, 32 * 6, gridDim.x - 1 - blockIdx.x, gridDim.x, smem_all, eq);
        }
        phase_mlaprep(p, j, 1);
      }
      GSYNC();
      for (int _r = 0; _r < opaque_int(REP_ATTN); ++_r) phase_attn(p, smem_all);
      GSYNC();
      {
        const f16* W = reinterpret_cast<const f16*>(p.ws + OFF_WO) + (size_t)j * 1024 * 1024;
        EpiResid epi{X, MOD + layer * 3 * 3072, layer == 0 ? p.x_prompt : X, layer == 0 ? p.x_sample : X + (size_t)4096 * 1024};
        gemm512<1, 2, 0, 0, 0>(A2, 1024, W, 1024, 1024, 32, 32 * 8, blockIdx.x, gridDim.x, smem_all, epi);
        for (int _r = 1; _r < opaque_int(REP_OUT); ++_r) gemm512<1, 2, 0, 0, 0>(A2, 1024, W, 1024, 1024, 32, 32 * 8, blockIdx.x, gridDim.x, smem_all, EpiNull{});
      }
      GSYNC();
    }
  }
  phase_final(p);
}

#undef smem
extern "C" void kernel_launch(void* const* d_in, const int* in_sizes, int n_in, void* d_out, int out_size,
                              void* d_ws, size_t ws_size, hipStream_t stream) {
  static int grid_blocks = 0;
  if (!grid_blocks) {
    int dev = 0, cus = 0, per_cu = 0;
    hipGetDevice(&dev);
    hipDeviceGetAttribute(&cus, hipDeviceAttributeMultiprocessorCount, dev);
    hipFuncSetAttribute((const void*)fwd_megakernel, hipFuncAttributeMaxDynamicSharedMemorySize, LDS_BYTES);
    hipOccupancyMaxActiveBlocksPerMultiprocessor(&per_cu, fwd_megakernel, 512, LDS_BYTES);
    if (per_cu > 1) per_cu = 1;
    if (per_cu < 1) per_cu = 1;
    grid_blocks = cus * per_cu;
  }
  Params p{};
  const float** pp = reinterpret_cast<const float**>(&p);
  for (int i = 0; i < 27; ++i) pp[i] = reinterpret_cast<const float*>(d_in[i]);
  p.out = reinterpret_cast<float*>(d_out);
  p.ws = reinterpret_cast<char*>(d_ws);
  hipMemsetAsync(p.ws + OFF_BAR, 0, XCD_BAR_WORDS * 4, stream);
  void* args[] = {&p};
  hipError_t e = hipLaunchCooperativeKernel((void*)fwd_megakernel, dim3(grid_blocks), dim3(512), args, LDS_BYTES, stream);
  if (e != hipSuccess) fprintf(stderr, "cooperative launch failed: %s (grid %d)\n", hipGetErrorString(e), grid_blocks);
}
```
